# Optimizing an MI355X kernel written in HIP

```python
import math
import jax, jax.numpy as jnp
from jax import lax
import numpy as np

D_MODEL = 1024
BATCH = 8
SEQ = 8192
DEPTH = 2
DEC_BATCH = 4
DEC_SEQ = 8192
PAST_LEN = 128

ATT_HEADS = 8
ATT_KV_HEADS = 2
ATT_GROUP = ATT_HEADS // ATT_KV_HEADS
HEAD_DIM = 64
WINDOW = 128
BLOCK = 128
REL_BUCKETS = 32
REL_MAX_DIST = 128
DN_HEADS = 8
DN_DK = 64
DN_DV = 64
DN_CONV = 3
DN_CHUNK = 64
D_FF = 2816
ALPHA = (2 * DEPTH) ** 0.25
BETA_INIT = (8 * DEPTH) ** -0.25
LN_EPS = 1e-5
RMS_EPS = 1e-6

ATT_Q = ATT_HEADS * HEAD_DIM
ATT_KV = ATT_KV_HEADS * HEAD_DIM
DN_K = DN_HEADS * DN_DK
DN_V = DN_HEADS * DN_DV
DN_QKV = 2 * DN_K + DN_V
IN_WIDTH = ATT_Q + 2 * ATT_KV + DN_QKV + DN_V + 4 * DN_HEADS
SPLIT_POINTS = (ATT_Q, ATT_Q + ATT_KV, ATT_Q + 2 * ATT_KV, ATT_Q + 2 * ATT_KV + DN_QKV,
                ATT_Q + 2 * ATT_KV + DN_QKV + DN_V, ATT_Q + 2 * ATT_KV + DN_QKV + DN_V + 2 * DN_HEADS)

kernel_name = 'hybrid_window_gdn_encoder'


def _layer_norm(x, g, b):
    xf = x.astype(jnp.float32)
    mu = jnp.mean(xf, -1, keepdims=True)
    var = jnp.mean(jnp.square(xf - mu), -1, keepdims=True)
    return ((xf - mu) * lax.rsqrt(var + LN_EPS) * g.astype(jnp.float32) + b.astype(jnp.float32)).astype(x.dtype)


def _swiglu(x, wg, wu, wd):
    return (jax.nn.silu(x @ wg) * (x @ wu)) @ wd


def _t5_buckets(rel):
    half = REL_BUCKETS // 2
    ret = (rel > 0).astype(np.int32) * half
    n = np.abs(rel)
    max_exact = half // 2
    large = max_exact + (np.log(np.maximum(n, 1) / max_exact) / np.log(REL_MAX_DIST / max_exact)
                         * (half - max_exact)).astype(np.int32)
    large = np.minimum(large, half - 1)
    return (ret + np.where(n < max_exact, n, large)).astype(np.int32)


def _band_bias_and_mask(rel_bias, s):
    nb = s // BLOCK
    i = np.arange(BLOCK)[:, None]
    j = np.arange(3 * BLOCK)[None, :]
    rel = j - BLOCK - i
    bias = rel_bias.astype(jnp.float32)[_t5_buckets(rel)]
    bias = jnp.transpose(bias, (2, 0, 1)).reshape(ATT_KV_HEADS, ATT_GROUP, BLOCK, 3 * BLOCK)
    key_pos = np.arange(nb)[:, None] * BLOCK + np.arange(3 * BLOCK)[None, :] - BLOCK
    inside = (key_pos >= 0) & (key_pos < s)
    valid = (np.abs(rel) <= WINDOW)[None] & inside[:, None, :]
    return bias, jnp.asarray(valid)


def _window_attention(q, k, v, sink, bias, valid):
    b, s, _ = q.shape
    nb = s // BLOCK
    qb = q.astype(jnp.float32).reshape(b, nb, BLOCK, ATT_KV_HEADS, ATT_GROUP, HEAD_DIM) * HEAD_DIM ** -0.5

    def windows(t):
        tp = jnp.pad(t.reshape(b, s, ATT_KV_HEADS, HEAD_DIM), ((0, 0), (BLOCK, BLOCK), (0, 0), (0, 0)))
        tp = tp.reshape(b, nb + 2, BLOCK, ATT_KV_HEADS, HEAD_DIM)
        return jnp.concatenate([tp[:, :-2], tp[:, 1:-1], tp[:, 2:]], axis=2).astype(jnp.float32)

    kw = windows(k)
    vw = windows(v)
    logits = jnp.einsum('bnqkgd,bnjkd->bnkgqj', qb, kw) + bias
    logits = jnp.where(valid[None, :, None, None], logits, -jnp.inf)
    sk = sink.astype(jnp.float32).reshape(ATT_KV_HEADS, ATT_GROUP, 1)
    m = jnp.maximum(jnp.max(logits, -1), sk)
    p = jnp.exp(logits - m[..., None])
    denom = jnp.sum(p, -1) + jnp.exp(sk - m)
    out = jnp.einsum('bnkgqj,bnjkd->bnqkgd', p / denom[..., None], vw)
    return out.reshape(b, s, ATT_Q).astype(q.dtype)


def _l2norm(t):
    return t * lax.rsqrt(jnp.sum(t * t, -1, keepdims=True) + 1e-6)


def _chunk_gated_delta_rule(q, k, v, log_g, beta):
    n, s, h, dk = q.shape
    dv = v.shape[-1]
    nc = s // DN_CHUNK

    def blk(t):
        return jnp.moveaxis(t.reshape(n, nc, DN_CHUNK, h, -1), 3, 1)

    qc, kc, vc = blk(q), blk(k), blk(v)
    gc = blk(log_g[..., None])[..., 0]
    bc = blk(beta[..., None])[..., 0]
    G = jnp.cumsum(gc, -1)
    idx = np.arange(DN_CHUNK)
    incl = jnp.asarray(idx[:, None] >= idx[None, :])
    strict = jnp.asarray(idx[:, None] > idx[None, :])
    decay = jnp.exp(jnp.where(incl, G[..., :, None] - G[..., None, :], -jnp.inf))
    a = jnp.where(strict, bc[..., :, None] * jnp.einsum('nhcid,nhcjd->nhcij', kc, kc) * decay, 0.0)
    eye = jnp.eye(DN_CHUNK, dtype=jnp.float32)
    t_inv = lax.linalg.triangular_solve(eye + a, jnp.broadcast_to(eye, a.shape),
                                        left_side=True, lower=True, unit_diagonal=True)
    eg = jnp.exp(G)
    u0 = t_inv @ (bc[..., None] * vc)
    w = t_inv @ ((bc * eg)[..., None] * kc)
    att = jnp.einsum('nhcid,nhcjd->nhcij', qc, kc) * decay
    qg = qc * eg[..., None]
    g_last = G[..., -1:]
    kd = kc * jnp.exp(g_last - G)[..., None]
    gl = jnp.exp(g_last)[..., 0]
    xs = (jnp.moveaxis(qg, 2, 0), jnp.moveaxis(w, 2, 0), jnp.moveaxis(u0, 2, 0),
          jnp.moveaxis(kd, 2, 0), jnp.moveaxis(att, 2, 0), jnp.moveaxis(gl, 2, 0))

    def step(state, inp):
        qg_c, w_c, u0_c, kd_c, att_c, gl_c = inp
        u = u0_c - w_c @ state
        o = qg_c @ state + att_c @ u
        state = state * gl_c[..., None, None] + jnp.swapaxes(kd_c, -1, -2) @ u
        return state, o

    s0 = jnp.zeros((n, h, dk, dv), jnp.float32)
    _, o = lax.scan(step, s0, xs)
    return jnp.transpose(o, (1, 0, 3, 2, 4)).reshape(n, s, h, dv)


def _bidir_gated_deltanet(qkv, z, a, bt, conv_w, a_log, dt_bias, norm_w):
    b, s, _ = qkv.shape
    pad = DN_CONV // 2
    xp = jnp.pad(qkv, ((0, 0), (pad, pad), (0, 0)))
    c = xp[:, 0:s] * conv_w[0]
    for j in range(1, DN_CONV):
        c = c + xp[:, j:j + s] * conv_w[j]
    c = jax.nn.silu(c).astype(jnp.float32)
    q, k, v = jnp.split(c, [DN_K, 2 * DN_K], axis=-1)
    q = _l2norm(q.reshape(b, s, DN_HEADS, DN_DK)) * DN_DK ** -0.5
    k = _l2norm(k.reshape(b, s, DN_HEADS, DN_DK))
    v = v.reshape(b, s, DN_HEADS, DN_DV)
    a = a.astype(jnp.float32).reshape(b, s, 2, DN_HEADS)
    log_g = -jnp.exp(a_log.astype(jnp.float32)) * jax.nn.softplus(a + dt_bias.astype(jnp.float32))
    beta = jax.nn.sigmoid(bt.astype(jnp.float32).reshape(b, s, 2, DN_HEADS))

    def both(t):
        return jnp.concatenate([t, jnp.flip(t, 1)], axis=0)

    o = _chunk_gated_delta_rule(both(q), both(k), both(v),
                                jnp.concatenate([log_g[:, :, 0], jnp.flip(log_g[:, :, 1], 1)], axis=0),
                                jnp.concatenate([beta[:, :, 0], jnp.flip(beta[:, :, 1], 1)], axis=0))
    o = o[:b] + jnp.flip(o[b:], 1)
    o = o * lax.rsqrt(jnp.mean(o * o, -1, keepdims=True) + RMS_EPS) * norm_w.astype(jnp.float32)
    o = o * jax.nn.silu(z.astype(jnp.float32).reshape(b, s, DN_HEADS, DN_DV))
    return o.reshape(b, s, DN_V).astype(qkv.dtype)


def _mixer(x, w_in, sink, bias, valid, conv_w, a_log, dt_bias, norm_w, w_att_out, w_dn_out, w_gate, b_gate, w_o):
    proj = x @ w_in
    qa, ka, va, qkv, z, a, bt = jnp.split(proj, SPLIT_POINTS, axis=-1)
    y_att = _window_attention(qa, ka, va, sink, bias, valid) @ w_att_out
    y_dn = _bidir_gated_deltanet(qkv, z, a, bt, conv_w, a_log, dt_bias, norm_w) @ w_dn_out
    g_att, g_dn = jnp.split(jax.nn.sigmoid(x @ w_gate + b_gate), 2, axis=-1)
    return (g_att * y_att + g_dn * y_dn) @ w_o


def _trunk(x, ln_g, ln_b, ffn_w_gate, ffn_w_up, ffn_w_down, w_in, attn_sink, rel_bias,
           dn_conv, dn_a_log, dn_dt_bias, dn_norm_w, w_att_out, w_dn_out, w_gate, b_gate, w_o):
    bias, valid = _band_bias_and_mask(rel_bias, x.shape[1])
    for l in range(DEPTH):
        x = _layer_norm(ALPHA * x + 0.5 * _swiglu(x, ffn_w_gate[l, 0], ffn_w_up[l, 0], ffn_w_down[l, 0]),
                        ln_g[l, 0], ln_b[l, 0])
        x = _layer_norm(ALPHA * x + _mixer(x, w_in[l], attn_sink[l], bias, valid, dn_conv[l], dn_a_log[l],
                                           dn_dt_bias[l], dn_norm_w[l], w_att_out[l], w_dn_out[l],
                                           w_gate[l], b_gate[l], w_o[l]),
                        ln_g[l, 1], ln_b[l, 1])
        x = _layer_norm(ALPHA * x + 0.5 * _swiglu(x, ffn_w_gate[l, 1], ffn_w_up[l, 1], ffn_w_down[l, 1]),
                        ln_g[l, 2], ln_b[l, 2])
    return x


def setup_inputs(seed: int = 0) -> dict:
    key = jax.random.key(seed)
    ks = jax.random.split(key, 20)
    f32 = jnp.float32

    def nrm(k, shape, scale):
        return jax.random.normal(k, shape, f32) * scale

    dt = jnp.exp(jax.random.uniform(ks[12], (DEPTH, 2, DN_HEADS), f32) * (math.log(0.1) - math.log(0.001))
                 + math.log(0.001))
    return {
        'x_prompt': nrm(ks[0], (BATCH, SEQ, D_MODEL), 1.0),
        'x_sample': nrm(ks[1], (DEC_BATCH, DEC_SEQ, D_MODEL), 1.0),
        'ln_g': 1.0 + nrm(ks[2], (DEPTH, 3, D_MODEL), 0.02),
        'ln_b': nrm(ks[3], (DEPTH, 3, D_MODEL), 0.02),
        'ffn_w_gate': nrm(ks[4], (DEPTH, 2, D_MODEL, D_FF), D_MODEL ** -0.5),
        'ffn_w_up': nrm(ks[5], (DEPTH, 2, D_MODEL, D_FF), D_MODEL ** -0.5),
        'ffn_w_down': nrm(ks[6], (DEPTH, 2, D_FF, D_MODEL), D_FF ** -0.5 * BETA_INIT),
        'w_in': nrm(ks[7], (DEPTH, D_MODEL, IN_WIDTH), D_MODEL ** -0.5),
        'attn_sink': nrm(ks[8], (DEPTH, ATT_HEADS), 1.0),
        'rel_bias': nrm(ks[9], (REL_BUCKETS, ATT_HEADS), 0.5),
        'dn_conv': nrm(ks[10], (DEPTH, DN_CONV, DN_QKV), DN_CONV ** -0.5),
        'dn_a_log': jnp.log(jax.random.uniform(ks[11], (DEPTH, 2, DN_HEADS), f32, 1.0, 16.0)),
        'dn_dt_bias': dt + jnp.log(-jnp.expm1(-dt)),
        'dn_norm_w': 1.0 + nrm(ks[13], (DEPTH, DN_DV), 0.02),
        'w_att_out': nrm(ks[14], (DEPTH, ATT_Q, D_MODEL), ATT_Q ** -0.5),
        'w_dn_out': nrm(ks[15], (DEPTH, DN_V, D_MODEL), DN_V ** -0.5),
        'w_gate': nrm(ks[16], (DEPTH, D_MODEL, 2 * D_MODEL), D_MODEL ** -0.5),
        'b_gate': nrm(ks[17], (DEPTH, 2 * D_MODEL), 0.02),
        'w_o': nrm(ks[18], (DEPTH, D_MODEL, D_MODEL), D_MODEL ** -0.5 * BETA_INIT),
    }


def reference(x_prompt, x_sample, ln_g, ln_b, ffn_w_gate, ffn_w_up, ffn_w_down, w_in, attn_sink, rel_bias,
              dn_conv, dn_a_log, dn_dt_bias, dn_norm_w, w_att_out, w_dn_out, w_gate, b_gate, w_o):
    y_prompt = _trunk(x_prompt, ln_g, ln_b, ffn_w_gate, ffn_w_up, ffn_w_down, w_in, attn_sink, rel_bias,
                      dn_conv, dn_a_log, dn_dt_bias, dn_norm_w, w_att_out, w_dn_out, w_gate, b_gate, w_o)
    y_sample = _trunk(x_sample, ln_g, ln_b, ffn_w_gate, ffn_w_up, ffn_w_down, w_in, attn_sink, rel_bias,
                      dn_conv, dn_a_log, dn_dt_bias, dn_norm_w, w_att_out, w_dn_out, w_gate, b_gate, w_o)
    return (y_prompt, y_sample)
```

```cpp
#include <hip/hip_runtime.h>
#include <hip/hip_cooperative_groups.h>
#include <cstdio>
namespace cg = cooperative_groups;

#define LAS __attribute__((address_space(3)))
typedef unsigned short bf16_t;
typedef short bf16x8 __attribute__((ext_vector_type(8)));
typedef float f32x4 __attribute__((ext_vector_type(4)));
typedef float f32x16 __attribute__((ext_vector_type(16)));
typedef unsigned u32x4 __attribute__((ext_vector_type(4)));
typedef unsigned u32x2 __attribute__((ext_vector_type(2)));

#ifndef SINGLE_LAUNCH
#define SINGLE_LAUNCH 1
#endif

constexpr int T_TOK = 98304, SEQ = 8192, NSEQ = 12, DM = 1024, DFF = 2816, T_PROMPT = 65536;
constexpr float ALPHA = 1.4142135623730951f;
constexpr int LDS_BYTES = 131072;
constexpr size_t W_GU0 = 0, W_GU1 = 5767168, W_D0 = 11534336, W_D1 = 14417920, W_PR = 17301504, W_GT = 20447232, W_AT = 22544384, W_DN = 23068672, W_WO = 23592960, W_LAYER = 24641536;
constexpr size_t XB_OFF = 98566144, REG_OFF = XB_OFF + 201326592;
constexpr size_t R_H = 0, R_AQ = 0, R_AKV = 100663296, R_DNR = 150994944, R_Z = 452984832, R_AB = 553648128, R_OF = 566231040, R_OB = 666894336, R_DNO = 150994944, R_M2 = 251658240, R_M = 566231040;
constexpr size_t WS_NEED = REG_OFF + 767557632;

struct P {
    const float *x_prompt, *x_sample, *ln_g, *ln_b, *w_fg, *w_fu, *w_fd, *w_in, *sink, *rel_bias, *conv, *a_log, *dt_bias, *norm_w, *w_att, *w_dn, *w_gate, *b_gate, *w_o;
    float* out; unsigned char* ws;
};

__device__ __forceinline__ int opaque_tid() { int t = threadIdx.x; asm volatile("" : "+v"(t)); return t; }
__device__ __forceinline__ unsigned pk_bf16(float lo, float hi) { unsigned r; asm("v_cvt_pk_bf16_f32 %0, %1, %2" : "=v"(r) : "v"(lo), "v"(hi)); return r; }
__device__ __forceinline__ float bf_lo(unsigned w) { return __uint_as_float(w << 16); }
__device__ __forceinline__ float bf_hi(unsigned w) { return __uint_as_float(w & 0xffff0000u); }
__device__ __forceinline__ float bf2f(bf16_t b) { return __uint_as_float(((unsigned)b) << 16); }
__device__ __forceinline__ float sigmoidf_(float x) { return __builtin_amdgcn_rcpf(1.0f + __expf(-x)); }
__device__ __forceinline__ float siluf_(float x) { return x * sigmoidf_(x); }

namespace pg8 {
constexpr int BM = 256, BK = 64, HALF = 128, HTB = HALF * BK * 2, NXCD = 8, WGM = 8;
__device__ __forceinline__ int lds_byte(int r, int c) { const int st = (r >> 4) * 2 + (c >> 5), rr = r & 15, cc = c & 31, ob = rr * 64 + cc * 2; return st * 1024 + (ob ^ (((ob >> 9) & 1) << 5)); }
__device__ __forceinline__ void stage_rc(int b, int& R, int& C) { const int st = b / 1024, sb = b % 1024, swz = sb ^ (((sb >> 9) & 1) << 5); R = (st >> 1) * 16 + swz / 64; C = (st & 1) * 32 + (swz % 64) / 2; }
__device__ __forceinline__ int perm32(int rho) { const int n = rho >> 4, i = rho & 15; return 8 * (i >> 2) + 4 * n + (i & 3); }
struct Unit { int pm, pn; };
struct Gemm { const bf16_t* A; const bf16_t* Bt; int M, N, K; };
struct StaticOrder {
    int nM, nN, nwg, G, c;
    __device__ void init(int M, int N, int G_, int c_) { nM = M / BM; nN = N / BM; nwg = nM * nN; G = G_; c = c_; }
    __device__ bool next(int i, Unit& u) const {
        const long L = (long)i * G + c; if (L >= nwg) return false;
        int wgid = (int)L; { const int q = nwg / NXCD, r = nwg % NXCD, xcd = wgid % NXCD, off = wgid / NXCD; wgid = (xcd < r ? xcd * (q + 1) : r * (q + 1) + (xcd - r) * q) + off; }
        const int nig = WGM * nN, gid = wgid / nig, fm = gid * WGM, gsz = (nM - fm) < WGM ? (nM - fm) : WGM;
        u.pm = fm + ((wgid % nig) % gsz); u.pn = (wgid % nig) / gsz; return true;
    }
};

template <class Epi>
__device__ __forceinline__ void gemm_phase(LAS unsigned char* lds, const Gemm g, const StaticOrder& S, const Epi& E) {
    const int tid = opaque_tid(), wid = __builtin_amdgcn_readfirstlane(tid >> 6), lane = tid & 63, wr = wid >> 2, wc = wid & 3, fr = lane & 15, fq = lane >> 4;
    const int K = g.K, nt = K / BK;
    unsigned voffA[2], voffB[2];
#pragma unroll
    for (int i = 0; i < 2; ++i) { int R, C; stage_rc(tid * 16 + i * 8192, R, C); const int Rb = Epi::PERM ? ((R & ~31) + perm32(R & 31)) : R;
        voffA[i] = (unsigned)(R * K + C) * 2u; voffB[i] = (unsigned)(Rb * K + C) * 2u; }
    const size_t kstep = (size_t)(BK * 2);
    const size_t hstep = (size_t)HALF * K * 2;
    const size_t tstep = 2 * hstep;
    const unsigned ldsw = (unsigned)wid * 1024u;
    const int aoff = lds_byte(wr * 64 + fr, fq * 8), boff = lds_byte(wc * 32 + fr, fq * 8);
#define PG8_SA(b, h) (((b) * 2 + (h)) * HTB)
#define PG8_SB(b, h) ((4 + (b) * 2 + (h)) * HTB)
#define PG8_STAGE(bufoff, gbase, voff) do { _Pragma("unroll") for (int _i = 0; _i < 2; ++_i) \
        __builtin_amdgcn_global_load_lds((const unsigned*)((const char*)(gbase) + (voff)[_i]), (LAS unsigned*)(lds + (bufoff) + ldsw + _i * 8192), 16, 0, 0); } while (0)
#define PG8_LDA(dst, b, h) do { _Pragma("unroll") for (int m = 0; m < 4; ++m) _Pragma("unroll") for (int k = 0; k < 2; ++k) dst[m][k] = *(const LAS bf16x8*)(lds + PG8_SA(b, h) + aoff + m * 2048 + k * 1024); } while (0)
#define PG8_LDB(dst, b, h) do { _Pragma("unroll") for (int n = 0; n < 2; ++n) _Pragma("unroll") for (int k = 0; k < 2; ++k) dst[n][k] = *(const LAS bf16x8*)(lds + PG8_SB(b, h) + boff + n * 2048 + k * 1024); } while (0)
#define PG8_MMA(ai, bj, At, Bt) do { __builtin_amdgcn_s_setprio(1); _Pragma("unroll") for (int m = 0; m < 4; ++m) _Pragma("unroll") for (int n = 0; n < 2; ++n) _Pragma("unroll") for (int k = 0; k < 2; ++k) \
        acc[ai][bj][m][n] = __builtin_amdgcn_mfma_f32_16x16x32_bf16(Bt[n][k], At[m][k], acc[ai][bj][m][n], 0, 0, 0); __builtin_amdgcn_s_setprio(0); } while (0)
#define PG8_WAIT_V(n) asm volatile("s_waitcnt vmcnt(" #n ")" ::: "memory")
#define PG8_WAIT_L(n) asm volatile("s_waitcnt lgkmcnt(" #n ")" ::: "memory")
#define PG8_BAR __builtin_amdgcn_s_barrier()
#define PG8_SCHED __builtin_amdgcn_sched_barrier(0)
    Unit cur, nxt; int ui = 0;
    if (!S.next(0, cur)) return;
    f32x4 acc[2][2][4][2];
#pragma unroll
    for (int a = 0; a < 2; ++a)
#pragma unroll
        for (int b = 0; b < 2; ++b)
#pragma unroll
            for (int m = 0; m < 4; ++m)
#pragma unroll
                for (int n = 0; n < 2; ++n) acc[a][b][m][n] = (f32x4){0.f, 0.f, 0.f, 0.f};
    bf16x8 At[4][2], B0[2][2], B1[2][2];
    const char* cA = (const char*)g.A + (size_t)cur.pm * tstep; const char* cB = (const char*)g.Bt + (size_t)cur.pn * tstep;
    PG8_STAGE(PG8_SB(0, 0), cB, voffB); PG8_STAGE(PG8_SA(0, 0), cA, voffA); PG8_STAGE(PG8_SB(0, 1), cB + hstep, voffB); PG8_STAGE(PG8_SA(0, 1), cA + hstep, voffA);
    if (wr == 1) PG8_BAR;
    PG8_WAIT_V(4); PG8_BAR;
    PG8_STAGE(PG8_SB(1, 0), cB + kstep, voffB); PG8_STAGE(PG8_SA(1, 0), cA + kstep, voffA); PG8_STAGE(PG8_SB(1, 1), cB + hstep + kstep, voffB);
    PG8_WAIT_V(6); PG8_BAR;
    for (;;) {
        const bool has_next = S.next(ui + 1, nxt);
        const char* nA = has_next ? (const char*)g.A + (size_t)nxt.pm * tstep : cA; const char* nB = has_next ? (const char*)g.Bt + (size_t)nxt.pn * tstep : cB;
        for (int t = 0; t < nt; t += 2) {
            const bool last = (t == nt - 2);
            const char* a1 = cA + (size_t)(t + 1) * kstep;
            const char* a2 = last ? nA : cA + (size_t)(t + 2) * kstep; const char* b2 = last ? nB : cB + (size_t)(t + 2) * kstep;
            const char* a3 = a2 + kstep; const char* b3 = b2 + kstep;
            PG8_LDB(B0, 0, 0); PG8_SCHED; PG8_LDA(At, 0, 0); PG8_STAGE(PG8_SA(1, 1), a1 + hstep, voffA);
            PG8_WAIT_L(8); PG8_BAR; PG8_WAIT_L(0); PG8_MMA(0, 0, At, B0); PG8_BAR; PG8_SCHED;
            PG8_LDB(B1, 0, 1); PG8_STAGE(PG8_SB(0, 0), b2, voffB);
            PG8_BAR; PG8_WAIT_L(0); PG8_MMA(0, 1, At, B1); PG8_BAR;
            PG8_LDA(At, 0, 1); PG8_STAGE(PG8_SA(0, 0), a2, voffA);
            PG8_BAR; PG8_WAIT_L(0); PG8_MMA(1, 0, At, B0); PG8_BAR; PG8_SCHED;
            PG8_STAGE(PG8_SB(0, 1), b2 + hstep, voffB);
            PG8_WAIT_V(6); PG8_BAR; PG8_MMA(1, 1, At, B1); PG8_BAR;
            PG8_LDB(B0, 1, 0); PG8_SCHED; PG8_LDA(At, 1, 0); PG8_STAGE(PG8_SA(0, 1), a2 + hstep, voffA);
            PG8_WAIT_L(8); PG8_BAR; PG8_WAIT_L(0); PG8_MMA(0, 0, At, B0); PG8_BAR; PG8_SCHED;
            PG8_LDB(B1, 1, 1); PG8_STAGE(PG8_SB(1, 0), b3, voffB);
            PG8_BAR; PG8_WAIT_L(0); PG8_MMA(0, 1, At, B1); PG8_BAR;
            PG8_LDA(At, 1, 1); PG8_STAGE(PG8_SA(1, 0), a3, voffA);
            PG8_BAR; PG8_WAIT_L(0); PG8_MMA(1, 0, At, B0); PG8_BAR; PG8_SCHED;
            PG8_STAGE(PG8_SB(1, 1), b3 + hstep, voffB);
            PG8_WAIT_V(6); PG8_BAR; PG8_MMA(1, 1, At, B1); PG8_BAR;
        }
        E(acc, cur, wr, wc, fr, fq);
        if (!has_next) break;
#pragma unroll
        for (int a = 0; a < 2; ++a)
#pragma unroll
            for (int b = 0; b < 2; ++b)
#pragma unroll
                for (int m = 0; m < 4; ++m)
#pragma unroll
                    for (int n = 0; n < 2; ++n) acc[a][b][m][n] = (f32x4){0.f, 0.f, 0.f, 0.f};
        cur = nxt; cA = nA; cB = nB; ++ui;
    }
    PG8_WAIT_V(0);
    if (wr == 0) PG8_BAR;
    PG8_BAR;
#undef PG8_SA
#undef PG8_SB
#undef PG8_STAGE
#undef PG8_LDA
#undef PG8_LDB
#undef PG8_MMA
#undef PG8_WAIT_V
#undef PG8_WAIT_L
#undef PG8_BAR
#undef PG8_SCHED
}
}
using pg8::Unit;

struct EpiResid {
    static constexpr bool PERM = false;
    const float* res0; const float* res1; int split_row; float* out; float s;
    __device__ __forceinline__ void operator()(const f32x4 (&acc)[2][2][4][2], const Unit& u, int wr, int wc, int fr, int fq) const {
        const int row0 = u.pm * 256 + wr * 64 + fr, col0 = u.pn * 256 + wc * 32 + 4 * fq;
#pragma unroll
        for (int ai = 0; ai < 2; ++ai)
#pragma unroll
            for (int m = 0; m < 4; ++m) {
                const int row = row0 + ai * 128 + m * 16;
                const float* rp = (row < split_row) ? res0 + (size_t)row * DM : res1 + (size_t)(row - split_row) * DM;
                float* op = out + (size_t)row * DM;
#pragma unroll
                for (int bj = 0; bj < 2; ++bj)
#pragma unroll
                    for (int n = 0; n < 2; ++n) { const int c = col0 + bj * 128 + n * 16; const f32x4 r = *(const f32x4*)(rp + c); *(f32x4*)(op + c) = r * ALPHA + acc[ai][bj][m][n] * s; }
            }
    }
};
struct EpiBf {
    static constexpr bool PERM = true;
    int mode;
    bf16_t* O; const bf16_t* O2; const float* bias; unsigned char* reg;
    __device__ __forceinline__ void operator()(const f32x4 (&acc)[2][2][4][2], const Unit& u, int wr, int wc, int fr, int fq) const {
        const int row0 = u.pm * 256 + wr * 64 + fr;
        if (mode == 0) {
            const int col0 = u.pn * 128 + wc * 32 + 8 * fq;
#pragma unroll
            for (int ai = 0; ai < 2; ++ai)
#pragma unroll
                for (int m = 0; m < 4; ++m) {
                    const int row = row0 + ai * 128 + m * 16;
                    const f32x4 g0 = acc[ai][0][m][0], g1 = acc[ai][0][m][1], u0 = acc[ai][1][m][0], u1 = acc[ai][1][m][1];
                    u32x4 w; w.x = pk_bf16(siluf_(g0[0]) * u0[0], siluf_(g0[1]) * u0[1]); w.y = pk_bf16(siluf_(g0[2]) * u0[2], siluf_(g0[3]) * u0[3]);
                    w.z = pk_bf16(siluf_(g1[0]) * u1[0], siluf_(g1[1]) * u1[1]); w.w = pk_bf16(siluf_(g1[2]) * u1[2], siluf_(g1[3]) * u1[3]);
                    *(u32x4*)(O + (size_t)row * DFF + col0) = w;
                }
        } else if (mode == 1) {
#pragma unroll
            for (int bj = 0; bj < 2; ++bj) {
                const int c0 = u.pn * 256 + bj * 128 + wc * 32 + 8 * fq;
                if (c0 >= 2848) continue;
                if (c0 >= 2816) {
                    float* ab = (float*)(reg + R_AB);
#pragma unroll
                    for (int ai = 0; ai < 2; ++ai)
#pragma unroll
                        for (int m = 0; m < 4; ++m) { const int row = row0 + ai * 128 + m * 16; float* q = ab + (size_t)row * 32 + (c0 - 2816); *(f32x4*)q = acc[ai][bj][m][0]; *(f32x4*)(q + 4) = acc[ai][bj][m][1]; }
                    continue;
                }
                bf16_t* bp; int ld;
                if (c0 < 512) { bp = (bf16_t*)(reg + R_AQ) + c0; ld = 512; }
                else if (c0 < 768) { bp = (bf16_t*)(reg + R_AKV) + (c0 - 512); ld = 256; }
                else if (c0 < 2304) { bp = (bf16_t*)(reg + R_DNR) + (c0 - 768); ld = 1536; }
                else { bp = (bf16_t*)(reg + R_Z) + (c0 - 2304); ld = 512; }
#pragma unroll
                for (int ai = 0; ai < 2; ++ai)
#pragma unroll
                    for (int m = 0; m < 4; ++m) { const int row = row0 + ai * 128 + m * 16; const f32x4 v0 = acc[ai][bj][m][0], v1 = acc[ai][bj][m][1];
                        u32x4 w; w.x = pk_bf16(v0[0], v0[1]); w.y = pk_bf16(v0[2], v0[3]); w.z = pk_bf16(v1[0], v1[1]); w.w = pk_bf16(v1[2], v1[3]);
                        *(u32x4*)(bp + (size_t)row * ld) = w; }
            }
        } else {
#pragma unroll
            for (int bj = 0; bj < 2; ++bj) {
                const int c0 = u.pn * 256 + bj * 128 + wc * 32 + 8 * fq;
                f32x4 b0 = (f32x4){0.f, 0.f, 0.f, 0.f}, b1 = b0;
                if (mode >= 3) { b0 = *(const f32x4*)(bias + c0); b1 = *(const f32x4*)(bias + c0 + 4); }
#pragma unroll
                for (int ai = 0; ai < 2; ++ai)
#pragma unroll
                    for (int m = 0; m < 4; ++m) { const int row = row0 + ai * 128 + m * 16; f32x4 v0 = acc[ai][bj][m][0], v1 = acc[ai][bj][m][1];
                        bf16_t* op = O + (size_t)row * DM + c0;
                        if (mode >= 3) {
                            const u32x4 o = *(const u32x4*)op;
                            f32x4 p0 = (f32x4){bf_lo(o.x), bf_hi(o.x), bf_lo(o.y), bf_hi(o.y)}, p1 = (f32x4){bf_lo(o.z), bf_hi(o.z), bf_lo(o.w), bf_hi(o.w)};
#pragma unroll
                            for (int j = 0; j < 4; ++j) { v0[j] = sigmoidf_(v0[j] + b0[j]); v1[j] = sigmoidf_(v1[j] + b1[j]); }
                            if (mode == 3) { v0 = v0 * p0; v1 = v1 * p1; }
                            else { const u32x4 o2 = *(const u32x4*)(O2 + (size_t)row * DM + c0);
                                const f32x4 q0 = (f32x4){bf_lo(o2.x), bf_hi(o2.x), bf_lo(o2.y), bf_hi(o2.y)}, q1 = (f32x4){bf_lo(o2.z), bf_hi(o2.z), bf_lo(o2.w), bf_hi(o2.w)};
                                v0 = p0 + v0 * q0; v1 = p1 + v1 * q1; }
                        }
                        u32x4 w; w.x = pk_bf16(v0[0], v0[1]); w.y = pk_bf16(v0[2], v0[3]); w.z = pk_bf16(v1[0], v1[1]); w.w = pk_bf16(v1[2], v1[3]);
                        *(u32x4*)op = w; }
            }
        }
    }
};

__device__ __forceinline__ void cvt_tile(LAS float* tile, const float* src, int ldsrc, int ncols_valid, float scale, bf16_t* dst, int lddst) {
    const int tid = opaque_tid();
#pragma unroll
    for (int e = 0; e < 8; ++e) { const int idx = tid + e * 512, kk = idx >> 6, cc = idx & 63; tile[kk * 65 + cc] = (cc < ncols_valid) ? src[(size_t)kk * ldsrc + cc] * scale : 0.f; }
    __syncthreads();
#pragma unroll
    for (int e = 0; e < 4; ++e) { const int idx = tid + e * 512, rr = idx >> 5, kp = idx & 31; *(unsigned*)(dst + (size_t)rr * lddst + 2 * kp) = pk_bf16(tile[(2 * kp) * 65 + rr], tile[(2 * kp + 1) * 65 + rr]); }
    __syncthreads();
}
__device__ __forceinline__ void cvt_plain(LAS float* tile, int t, const float* src, bf16_t* dst, int K, int Nsrc, int qscale_rows) {
    const int nk = K / 64, rb = t / nk, kb = t % nk, r0 = rb * 64, k0 = kb * 64;
    int nv = Nsrc - r0; nv = nv > 64 ? 64 : (nv < 0 ? 0 : nv);
    cvt_tile(tile, src + (size_t)k0 * Nsrc + r0, Nsrc, nv, r0 < qscale_rows ? 0.125f : 1.0f, dst + (size_t)r0 * K + k0, K);
}
__device__ void phase_convert(const P& p, LAS unsigned char* lds) {
    LAS float* tile = (LAS float*)lds;
    bf16_t* W = (bf16_t*)p.ws;
    const int G = gridDim.x;
    for (int t = blockIdx.x; t < 12032; t += G) {
        const int l = t / 6016; int r = t % 6016;
        bf16_t* Wl = W + (size_t)l * W_LAYER;
        if (r < 2816) {
            const int f = r / 1408; r %= 1408; const int rb = r / 16, kb = r % 16, r0 = rb * 64, k0 = kb * 64;
            const int pn = r0 >> 8, x = r0 & 255;
            const float* src = (x < 128 ? p.w_fg : p.w_fu) + (size_t)(l * 2 + f) * DM * DFF + (size_t)k0 * DFF + pn * 128 + (x & 127);
            cvt_tile(tile, src, DFF, 64, 1.0f, Wl + (f ? W_GU1 : W_GU0) + (size_t)r0 * DM + k0, DM);
        } else if (r < 4224) {
            r -= 2816; const int f = r / 704; r %= 704;
            cvt_plain(tile, r, p.w_fd + (size_t)(l * 2 + f) * DFF * DM, Wl + (f ? W_D1 : W_D0), DFF, DM, 0);
        } else if (r < 4992) { cvt_plain(tile, r - 4224, p.w_in + (size_t)l * DM * 2848, Wl + W_PR, DM, 2848, 512); }
        else if (r < 5504) { cvt_plain(tile, r - 4992, p.w_gate + (size_t)l * DM * 2048, Wl + W_GT, DM, 2048, 0); }
        else if (r < 5632) { cvt_plain(tile, r - 5504, p.w_att + (size_t)l * 512 * DM, Wl + W_AT, 512, DM, 0); }
        else if (r < 5760) { cvt_plain(tile, r - 5632, p.w_dn + (size_t)l * 512 * DM, Wl + W_DN, 512, DM, 0); }
        else { cvt_plain(tile, r - 5760, p.w_o + (size_t)l * DM * DM, Wl + W_WO, DM, DM, 0); }
    }
    bf16_t* xb = (bf16_t*)(p.ws + XB_OFF);
    const size_t n8 = (size_t)T_TOK * DM / 8, split8 = (size_t)T_PROMPT * DM / 8;
    for (size_t i = (size_t)blockIdx.x * 512 + opaque_tid(); i < n8; i += (size_t)G * 512) {
        const float* s = (i < split8) ? p.x_prompt + i * 8 : p.x_sample + (i - split8) * 8;
        const f32x4 a = *(const f32x4*)s, b = *(const f32x4*)(s + 4);
        u32x4 w; w.x = pk_bf16(a[0], a[1]); w.y = pk_bf16(a[2], a[3]); w.z = pk_bf16(b[0], b[1]); w.w = pk_bf16(b[2], b[3]);
        *(u32x4*)(xb + i * 8) = w;
    }
}

__device__ __forceinline__ float wave_sum(float v) {
    v += __shfl_xor(v, 32); v += __shfl_xor(v, 16); v += __shfl_xor(v, 8); v += __shfl_xor(v, 4); v += __shfl_xor(v, 2); v += __shfl_xor(v, 1); return v;
}
__device__ void phase_ln(const P& p, int lnidx) {
    const int tid_ = opaque_tid(), wid = tid_ >> 6, lane = tid_ & 63;
    const float* g = p.ln_g + (size_t)lnidx * DM; const float* b = p.ln_b + (size_t)lnidx * DM;
    bf16_t* xb = (bf16_t*)(p.ws + XB_OFF);
    f32x4 gv[4], bv[4];
#pragma unroll
    for (int i = 0; i < 4; ++i) { gv[i] = *(const f32x4*)(g + i * 256 + lane * 4); bv[i] = *(const f32x4*)(b + i * 256 + lane * 4); }
    for (int row = blockIdx.x * 8 + wid; row < T_TOK; row += gridDim.x * 8) {
        float* xp = p.out + (size_t)row * DM;
        f32x4 v[4]; float s = 0.f;
#pragma unroll
        for (int i = 0; i < 4; ++i) { v[i] = *(const f32x4*)(xp + i * 256 + lane * 4); s += (v[i][0] + v[i][1]) + (v[i][2] + v[i][3]); }
        const float mean = wave_sum(s) * (1.0f / 1024.0f);
        float q = 0.f;
#pragma unroll
        for (int i = 0; i < 4; ++i) { const f32x4 d = v[i] - mean; q += (d[0] * d[0] + d[1] * d[1]) + (d[2] * d[2] + d[3] * d[3]); }
        const float rstd = rsqrtf(wave_sum(q) * (1.0f / 1024.0f) + 1e-5f);
#pragma unroll
        for (int i = 0; i < 4; ++i) {
            const f32x4 y = (v[i] - mean) * rstd * gv[i] + bv[i];
            *(f32x4*)(xp + i * 256 + lane * 4) = y;
            u32x2 w; w.x = pk_bf16(y[0], y[1]); w.y = pk_bf16(y[2], y[3]);
            *(u32x2*)(xb + (size_t)row * DM + i * 256 + lane * 4) = w;
        }
    }
}

__device__ __forceinline__ int t5_bucket(int rel) {
    const int n = rel < 0 ? -rel : rel;
    const int b = n < 8 ? n : n < 12 ? 8 : n < 16 ? 9 : n < 23 ? 10 : n < 32 ? 11 : n < 46 ? 12 : n < 64 ? 13 : n < 91 ? 14 : 15;
    return b + (rel > 0 ? 16 : 0);
}
constexpr int AT_KS = 0, AT_VT = 55296, AT_TB = 104960;
__device__ void attn_item(const P& p, int layer, int item, LAS unsigned char* lds) {
    const int tid = opaque_tid(), wid = tid >> 6, lane = tid & 63;
    const int kvh = item & 1, nb = (item >> 1) & 63, s = item >> 7;
    unsigned char* reg = p.ws + REG_OFF;
    bf16_t* AQ = (bf16_t*)(reg + R_AQ); const bf16_t* AKV = (const bf16_t*)(reg + R_AKV);
    LAS float* tb = (LAS float*)(lds + AT_TB);
    for (int c = tid; c < 3072; c += 512) {
        const int j = c >> 3, dc = c & 7, pos = nb * 128 - 128 + j;
        u32x4 kv = (u32x4){0u, 0u, 0u, 0u}, vv = kv;
        if (pos >= 0 && pos < SEQ) { const bf16_t* rp = AKV + (size_t)(s * SEQ + pos) * 256 + kvh * 64 + dc * 8; kv = *(const u32x4*)rp; vv = *(const u32x4*)(rp + 128); }
        *(LAS u32x4*)(lds + AT_KS + j * 144 + dc * 16) = kv;
        LAS bf16_t* vt = (LAS bf16_t*)(lds + AT_VT) + (dc * 8) * 388 + j;
        vt[0 * 388] = (bf16_t)(vv.x & 0xffffu); vt[1 * 388] = (bf16_t)(vv.x >> 16); vt[2 * 388] = (bf16_t)(vv.y & 0xffffu); vt[3 * 388] = (bf16_t)(vv.y >> 16);
        vt[4 * 388] = (bf16_t)(vv.z & 0xffffu); vt[5 * 388] = (bf16_t)(vv.z >> 16); vt[6 * 388] = (bf16_t)(vv.w & 0xffffu); vt[7 * 388] = (bf16_t)(vv.w >> 16);
    }
    for (int i = tid; i < 4 * 257; i += 512) { const int g = i / 257, r = i % 257; tb[g * 260 + r] = p.rel_bias[t5_bucket(r - 128) * 8 + kvh * 4 + g]; }
    __syncthreads();
    const int n = lane & 31, h = lane >> 5;
#pragma unroll 1
    for (int pp = 0; pp < 2; ++pp) {
        const int pair = wid + 8 * pp, g = pair & 3, qs = pair >> 2, hq = kvh * 4 + g, i = 32 * qs + n;
        bf16_t* qrow = AQ + (size_t)(s * SEQ + nb * 128 + i) * 512 + hq * 64;
        bf16x8 qf[4];
#pragma unroll
        for (int ks = 0; ks < 4; ++ks) qf[ks] = *(const bf16x8*)(qrow + 16 * ks + 8 * h);
        float m_run = p.sink[layer * 8 + hq], l_run = (h == 0) ? 1.0f : 0.0f;
        f32x16 o0, o1;
#pragma unroll
        for (int r = 0; r < 16; ++r) { o0[r] = 0.f; o1[r] = 0.f; }
#pragma unroll 1
        for (int kt = qs; kt <= qs + 8; ++kt) {
            f32x16 sa;
#pragma unroll
            for (int r = 0; r < 16; ++r) sa[r] = 0.f;
#pragma unroll
            for (int ks = 0; ks < 4; ++ks) { const bf16x8 kf = *(const LAS bf16x8*)(lds + AT_KS + (32 * kt + n) * 144 + (16 * ks + 8 * h) * 2); sa = __builtin_amdgcn_mfma_f32_32x32x16_bf16(kf, qf[ks], sa, 0, 0, 0); }
            float mx = m_run;
#pragma unroll
            for (int r = 0; r < 16; ++r) {
                const int kr = (r & 3) + 8 * (r >> 2) + 4 * h, j = 32 * kt + kr, rel = j - 128 - i, pos = nb * 128 - 128 + j;
                const bool valid = (rel >= -128) && (rel <= 128) && (pos >= 0) && (pos < SEQ);
                int ri = rel + 128; ri = ri < 0 ? 0 : (ri > 256 ? 256 : ri);
                const float v = valid ? sa[r] + tb[g * 260 + ri] : -1e30f;
                sa[r] = v; mx = fmaxf(mx, v);
            }
            mx = fmaxf(mx, __shfl_xor(mx, 32));
            const float corr = __expf(m_run - mx); m_run = mx;
            float ps = 0.f;
#pragma unroll
            for (int r = 0; r < 16; ++r) { const float e = __expf(sa[r] - mx); sa[r] = e; ps += e; }
            l_run = l_run * corr + ps;
#pragma unroll
            for (int r = 0; r < 16; ++r) { o0[r] *= corr; o1[r] *= corr; }
#pragma unroll
            for (int s2 = 0; s2 < 2; ++s2) {
                u32x4 pw; pw.x = pk_bf16(sa[8 * s2 + 0], sa[8 * s2 + 1]); pw.y = pk_bf16(sa[8 * s2 + 2], sa[8 * s2 + 3]); pw.z = pk_bf16(sa[8 * s2 + 4], sa[8 * s2 + 5]); pw.w = pk_bf16(sa[8 * s2 + 6], sa[8 * s2 + 7]);
                const bf16x8 pf = __builtin_bit_cast(bf16x8, pw);
                const int jb = 32 * kt + 16 * s2 + 4 * h;
#pragma unroll
                for (int dt = 0; dt < 2; ++dt) {
                    const LAS unsigned char* vp = lds + AT_VT + (32 * dt + n) * 776 + jb * 2;
                    const u32x2 lo = *(const LAS u32x2*)vp, hi = *(const LAS u32x2*)(vp + 16);
                    const u32x4 vw = (u32x4){lo.x, lo.y, hi.x, hi.y};
                    const bf16x8 vf = __builtin_bit_cast(bf16x8, vw);
                    if (dt == 0) o0 = __builtin_amdgcn_mfma_f32_32x32x16_bf16(vf, pf, o0, 0, 0, 0); else o1 = __builtin_amdgcn_mfma_f32_32x32x16_bf16(vf, pf, o1, 0, 0, 0);
                }
            }
        }
        const float inv = 1.0f / (l_run + __shfl_xor(l_run, 32));
#pragma unroll
        for (int a = 0; a < 4; ++a) {
            u32x2 w0, w1;
            w0.x = pk_bf16(o0[4 * a] * inv, o0[4 * a + 1] * inv); w0.y = pk_bf16(o0[4 * a + 2] * inv, o0[4 * a + 3] * inv);
            w1.x = pk_bf16(o1[4 * a] * inv, o1[4 * a + 1] * inv); w1.y = pk_bf16(o1[4 * a + 2] * inv, o1[4 * a + 3] * inv);
            *(u32x2*)(qrow + 8 * a + 4 * h) = w0; *(u32x2*)(qrow + 32 + 8 * a + 4 * h) = w1;
        }
    }
    __syncthreads();
}

__device__ void gdn_chain(const P& p, int layer, int chain, LAS unsigned char* lds) {
    const int lane = opaque_tid() & 63;
    const int hd = chain & 7, dir = (chain >> 3) & 1, s = chain >> 4;
    unsigned char* reg = p.ws + REG_OFF;
    const bf16_t* dnr = (const bf16_t*)(reg + R_DNR) + (size_t)s * SEQ * 1536 + hd * 64 + lane;
    const float* ab = (const float*)(reg + R_AB) + (size_t)s * SEQ * 32 + dir * 8 + hd;
    bf16_t* op = (bf16_t*)(reg + (dir ? R_OB : R_OF)) + (size_t)s * SEQ * 512 + hd * 64 + lane;
    const float* cw = p.conv + (size_t)layer * 3 * 1536 + hd * 64 + lane;
    const float wq0 = cw[0], wq1 = cw[1536], wq2 = cw[3072], wk0 = cw[512], wk1 = cw[512 + 1536], wk2 = cw[512 + 3072], wv0 = cw[1024], wv1 = cw[1024 + 1536], wv2 = cw[1024 + 3072];
    const float neg_ea = -__expf(p.a_log[layer * 16 + dir * 8 + hd]), dtb = p.dt_bias[layer * 16 + dir * 8 + hd];
    LAS float* kq = (LAS float*)lds;
    LAS float* vl = (LAS float*)(lds + 4096);
    LAS f32x4* scal = (LAS f32x4*)(lds + 6144);
    float S[64];
#pragma unroll
    for (int d = 0; d < 64; ++d) S[d] = 0.f;
#pragma unroll 1
    for (int blk = 0; blk < SEQ / 8; ++blk) {
        const int lowpos = dir ? (SEQ - 8 - blk * 8) : blk * 8;
        float rq[10], rk[10], rv[10];
#pragma unroll
        for (int i = 0; i < 10; ++i) {
            const int pos = lowpos - 1 + i; const bool ok = (pos >= 0) && (pos < SEQ);
            const bf16_t* rp = dnr + (size_t)(ok ? pos : 0) * 1536;
            rq[i] = ok ? bf2f(rp[0]) : 0.f; rk[i] = ok ? bf2f(rp[512]) : 0.f; rv[i] = ok ? bf2f(rp[1024]) : 0.f;
        }
#pragma unroll
        for (int j = 0; j < 8; ++j) {
            const float av = ab[(size_t)(lowpos + j) * 32], bt = ab[(size_t)(lowpos + j) * 32 + 16];
            const float cq = siluf_(wq0 * rq[j] + wq1 * rq[j + 1] + wq2 * rq[j + 2]);
            const float ck = siluf_(wk0 * rk[j] + wk1 * rk[j + 1] + wk2 * rk[j + 2]);
            const float cv = siluf_(wv0 * rv[j] + wv1 * rv[j + 1] + wv2 * rv[j + 2]);
            const float sq = wave_sum(cq * cq), sk = wave_sum(ck * ck);
            const float x = av + dtb; const float sp = x > 20.f ? x : log1pf(__expf(x));
            kq[j * 128 + lane] = ck; kq[j * 128 + 64 + lane] = cq; vl[j * 64 + lane] = cv;
            if (lane == 0) scal[j] = (f32x4){rsqrtf(sk + 1e-6f), rsqrtf(sq + 1e-6f) * 0.125f, __expf(neg_ea * sp), sigmoidf_(bt)};
        }
#pragma unroll 1
        for (int e = 0; e < 8; ++e) {
            const int j = dir ? 7 - e : e;
            const f32x4 sc = scal[j]; const float v = vl[j * 64 + lane];
            f32x4 kk[16];
            float r0 = 0.f, r1 = 0.f, r2 = 0.f, r3 = 0.f;
#pragma unroll
            for (int dd = 0; dd < 16; ++dd) { kk[dd] = *(const LAS f32x4*)(kq + j * 128 + 4 * dd); r0 += kk[dd][0] * S[4 * dd]; r1 += kk[dd][1] * S[4 * dd + 1]; r2 += kk[dd][2] * S[4 * dd + 2]; r3 += kk[dd][3] * S[4 * dd + 3]; }
            const float rr = sc[0] * ((r0 + r1) + (r2 + r3));
            const float kc = sc[0] * sc[3] * (v - sc[2] * rr);
            const float eg = sc[2];
            float o0 = 0.f, o1 = 0.f, o2 = 0.f, o3 = 0.f;
#pragma unroll
            for (int dd = 0; dd < 16; ++dd) {
                const f32x4 qq = *(const LAS f32x4*)(kq + j * 128 + 64 + 4 * dd);
                S[4 * dd] = eg * S[4 * dd] + kk[dd][0] * kc; S[4 * dd + 1] = eg * S[4 * dd + 1] + kk[dd][1] * kc; S[4 * dd + 2] = eg * S[4 * dd + 2] + kk[dd][2] * kc; S[4 * dd + 3] = eg * S[4 * dd + 3] + kk[dd][3] * kc;
                o0 += qq[0] * S[4 * dd]; o1 += qq[1] * S[4 * dd + 1]; o2 += qq[2] * S[4 * dd + 2]; o3 += qq[3] * S[4 * dd + 3];
            }
            const float o = sc[1] * ((o0 + o1) + (o2 + o3));
            op[(size_t)(lowpos + j) * 512] = (bf16_t)(pk_bf16(o, 0.f) & 0xffffu);
        }
    }
}
__device__ void phase_mix(const P& p, int layer, LAS unsigned char* lds) {
    const int G = gridDim.x, b = blockIdx.x, wid = threadIdx.x >> 6;
    const int nscan = G < 192 ? G : 192;
    if (b < nscan && wid == 0) for (int chain = b; chain < 192; chain += nscan) gdn_chain(p, layer, chain, lds);
    const int na = G - nscan;
    if (na > 0) { if (b >= nscan) for (int item = b - nscan; item < 1536; item += na) attn_item(p, layer, item, lds); }
    else { __syncthreads(); for (int item = b; item < 1536; item += G) attn_item(p, layer, item, lds); }
}
__device__ void phase_combine(const P& p, int layer) {
    const int tid_ = opaque_tid(), wid = tid_ >> 6, lane = tid_ & 63, c0 = lane * 8;
    unsigned char* reg = p.ws + REG_OFF;
    const bf16_t* OF = (const bf16_t*)(reg + R_OF); const bf16_t* OB = (const bf16_t*)(reg + R_OB); const bf16_t* Z = (const bf16_t*)(reg + R_Z);
    bf16_t* DNO = (bf16_t*)(reg + R_DNO);
    const float* nwp = p.norm_w + layer * 64 + (c0 & 63);
    const f32x4 nw0 = *(const f32x4*)nwp, nw1 = *(const f32x4*)(nwp + 4);
    for (int tok = blockIdx.x * 8 + wid; tok < T_TOK; tok += gridDim.x * 8) {
        const size_t off = (size_t)tok * 512 + c0;
        const u32x4 a = *(const u32x4*)(OF + off), b = *(const u32x4*)(OB + off), z = *(const u32x4*)(Z + off);
        float o[8] = {bf_lo(a.x) + bf_lo(b.x), bf_hi(a.x) + bf_hi(b.x), bf_lo(a.y) + bf_lo(b.y), bf_hi(a.y) + bf_hi(b.y), bf_lo(a.z) + bf_lo(b.z), bf_hi(a.z) + bf_hi(b.z), bf_lo(a.w) + bf_lo(b.w), bf_hi(a.w) + bf_hi(b.w)};
        const float zz[8] = {bf_lo(z.x), bf_hi(z.x), bf_lo(z.y), bf_hi(z.y), bf_lo(z.z), bf_hi(z.z), bf_lo(z.w), bf_hi(z.w)};
        float ss = 0.f;
#pragma unroll
        for (int e = 0; e < 8; ++e) ss += o[e] * o[e];
        ss += __shfl_xor(ss, 1); ss += __shfl_xor(ss, 2); ss += __shfl_xor(ss, 4);
        const float rs = rsqrtf(ss * (1.0f / 64.0f) + 1e-6f);
#pragma unroll
        for (int e = 0; e < 8; ++e) o[e] = o[e] * rs * (e < 4 ? nw0[e & 3] : nw1[e & 3]) * siluf_(zz[e]);
        u32x4 w; w.x = pk_bf16(o[0], o[1]); w.y = pk_bf16(o[2], o[3]); w.z = pk_bf16(o[4], o[5]); w.w = pk_bf16(o[6], o[7]);
        *(u32x4*)(DNO + off) = w;
    }
}

constexpr int PH_PER_LAYER = 12, NPH = 1 + 2 * PH_PER_LAYER;
__device__ void run_phase(const P& p, int ph, LAS unsigned char* lds) {
    if (ph == 0) { phase_convert(p, lds); return; }
    const int l = (ph - 1) / PH_PER_LAYER, q = (ph - 1) % PH_PER_LAYER;
    unsigned char* reg = p.ws + REG_OFF;
    const bf16_t* W = (const bf16_t*)p.ws + (size_t)l * W_LAYER;
    bf16_t* xb = (bf16_t*)(p.ws + XB_OFF);
    pg8::StaticOrder S;
    switch (q) {
    case 0: case 9: {
        S.init(T_TOK, 2 * DFF, gridDim.x, blockIdx.x);
        EpiBf E; E.mode = 0; E.O = (bf16_t*)(reg + R_H); E.O2 = nullptr; E.bias = nullptr; E.reg = reg;
        pg8::gemm_phase(lds, pg8::Gemm{xb, W + (q == 0 ? W_GU0 : W_GU1), T_TOK, 2 * DFF, DM}, S, E);
    } break;
    case 1: case 10: {
        S.init(T_TOK, DM, gridDim.x, blockIdx.x);
        EpiResid E; E.out = p.out; E.s = 0.5f;
        if (l == 0 && q == 1) { E.res0 = p.x_prompt; E.res1 = p.x_sample; E.split_row = T_PROMPT; } else { E.res0 = p.out; E.res1 = p.out; E.split_row = T_TOK; }
        pg8::gemm_phase(lds, pg8::Gemm{(const bf16_t*)(reg + R_H), W + (q == 1 ? W_D0 : W_D1), T_TOK, DM, DFF}, S, E);
    } break;
    case 2: phase_ln(p, l * 3 + 0); break;
    case 8: phase_ln(p, l * 3 + 1); break;
    case 11: phase_ln(p, l * 3 + 2); break;
    case 3: {
        S.init(T_TOK, 3072, gridDim.x, blockIdx.x);
        EpiBf E; E.mode = 1; E.O = nullptr; E.O2 = nullptr; E.bias = nullptr; E.reg = reg;
        pg8::gemm_phase(lds, pg8::Gemm{xb, W + W_PR, T_TOK, 3072, DM}, S, E);
    } break;
    case 4: phase_mix(p, l, lds); break;
    case 5: phase_combine(p, l); break;
    case 6: {
        S.init(T_TOK, DM, gridDim.x, blockIdx.x);
        EpiBf E; E.reg = reg; E.O = (bf16_t*)(reg + R_M); E.O2 = (const bf16_t*)(reg + R_M2); E.bias = nullptr;
        E.mode = 2; pg8::gemm_phase(lds, pg8::Gemm{(const bf16_t*)(reg + R_AQ), W + W_AT, T_TOK, DM, 512}, S, E);
        E.mode = 3; E.bias = p.b_gate + (size_t)l * 2048; pg8::gemm_phase(lds, pg8::Gemm{xb, W + W_GT, T_TOK, DM, DM}, S, E);
        E.mode = 2; E.O = (bf16_t*)(reg + R_M2); pg8::gemm_phase(lds, pg8::Gemm{(const bf16_t*)(reg + R_DNO), W + W_DN, T_TOK, DM, 512}, S, E);
        E.mode = 4; E.O = (bf16_t*)(reg + R_M); E.bias = p.b_gate + (size_t)l * 2048 + 1024; pg8::gemm_phase(lds, pg8::Gemm{xb, W + W_GT + (size_t)DM * DM, T_TOK, DM, DM}, S, E);
    } break;
    case 7: {
        S.init(T_TOK, DM, gridDim.x, blockIdx.x);
        EpiResid E; E.out = p.out; E.s = 1.0f; E.res0 = p.out; E.res1 = p.out; E.split_row = T_TOK;
        pg8::gemm_phase(lds, pg8::Gemm{(const bf16_t*)(reg + R_M), W + W_WO, T_TOK, DM, DM}, S, E);
    } break;
    }
}

__global__ __launch_bounds__(512, 2) void mega(P p, int ph_lo, int ph_hi) {
    extern __shared__ __attribute__((aligned(16))) unsigned char shm[];
    LAS unsigned char* lds = (LAS unsigned char*)shm;
    for (int ph = ph_lo; ph < ph_hi; ++ph) {
        if (ph > ph_lo) cg::this_grid().sync();
        run_phase(p, ph, lds);
    }
}

extern "C" void kernel_launch(void* const* d_in, const int* in_sizes, int n_in, void* d_out, int out_size, void* d_ws, size_t ws_size, hipStream_t stream) {
    static int grid_blocks = 0;
    if (!grid_blocks) {
        hipFuncSetAttribute((const void*)mega, hipFuncAttributeMaxDynamicSharedMemorySize, LDS_BYTES);
        int dev = 0, cus = 0, per_cu = 0;
        hipGetDevice(&dev);
        hipDeviceGetAttribute(&cus, hipDeviceAttributeMultiprocessorCount, dev);
        hipOccupancyMaxActiveBlocksPerMultiprocessor(&per_cu, mega, 512, LDS_BYTES);
        if (per_cu < 1) per_cu = 1;
        if (per_cu > 1) per_cu = 1;
        grid_blocks = cus * per_cu;
        if (ws_size < WS_NEED) fprintf(stderr, "workspace too small: %zu < %zu\n", ws_size, (size_t)WS_NEED);
    }
    P p{};
    p.x_prompt = (const float*)d_in[0]; p.x_sample = (const float*)d_in[1]; p.ln_g = (const float*)d_in[2]; p.ln_b = (const float*)d_in[3];
    p.w_fg = (const float*)d_in[4]; p.w_fu = (const float*)d_in[5]; p.w_fd = (const float*)d_in[6]; p.w_in = (const float*)d_in[7];
    p.sink = (const float*)d_in[8]; p.rel_bias = (const float*)d_in[9]; p.conv = (const float*)d_in[10]; p.a_log = (const float*)d_in[11];
    p.dt_bias = (const float*)d_in[12]; p.norm_w = (const float*)d_in[13]; p.w_att = (const float*)d_in[14]; p.w_dn = (const float*)d_in[15];
    p.w_gate = (const float*)d_in[16]; p.b_gate = (const float*)d_in[17]; p.w_o = (const float*)d_in[18];
    p.out = (float*)d_out; p.ws = (unsigned char*)d_ws;
#if SINGLE_LAUNCH
    int lo = 0, hi = NPH;
    void* args[] = {&p, &lo, &hi};
    hipError_t e = hipLaunchCooperativeKernel((const void*)mega, dim3(grid_blocks), dim3(512), args, LDS_BYTES, stream);
    if (e != hipSuccess) fprintf(stderr, "cooperative launch failed: %s (grid %d)\n", hipGetErrorString(e), grid_blocks);
#else
    for (int ph = 0; ph < NPH; ++ph) mega<<<dim3(grid_blocks), dim3(512), LDS_BYTES, stream>>>(p, ph, ph + 1);
#endif
}
```

```cpp
#include <hip/hip_runtime.h>
#include <hip/hip_cooperative_groups.h>
#include <cstdio>
namespace cg = cooperative_groups;

#define LAS __attribute__((address_space(3)))
typedef unsigned short bf16_t;
typedef short bf16x8 __attribute__((ext_vector_type(8)));
typedef float f32x4 __attribute__((ext_vector_type(4)));
typedef float f32x16 __attribute__((ext_vector_type(16)));
typedef unsigned u32x4 __attribute__((ext_vector_type(4)));
typedef unsigned u32x2 __attribute__((ext_vector_type(2)));

#ifndef SINGLE_LAUNCH
#define SINGLE_LAUNCH 1
#endif

constexpr int T_TOK = 98304, SEQ = 8192, NSEQ = 12, DM = 1024, DFF = 2816, T_PROMPT = 65536;
constexpr float ALPHA = 1.4142135623730951f;
constexpr int LDS_BYTES = 147456;
constexpr size_t W_GU0 = 0, W_GU1 = 5767168, W_D0 = 11534336, W_D1 = 14417920, W_PR = 17301504, W_GT = 20447232, W_AT = 22544384, W_DN = 23068672, W_WO = 23592960, W_LAYER = 24641536;
constexpr size_t XB_OFF = 98566144, REG_OFF = XB_OFF + 201326592;
constexpr size_t R_H = 0, R_AQ = 0, R_AKV = 100663296, R_DNR = 150994944, R_Z = 452984832, R_AB = 553648128, R_OF = 566231040, R_OB = 666894336, R_DNO = 150994944, R_M2 = 251658240, R_M = 566231040;
constexpr size_t WS_NEED = REG_OFF + 767557632;

struct P {
    const float *x_prompt, *x_sample, *ln_g, *ln_b, *w_fg, *w_fu, *w_fd, *w_in, *sink, *rel_bias, *conv, *a_log, *dt_bias, *norm_w, *w_att, *w_dn, *w_gate, *b_gate, *w_o;
    float* out; unsigned char* ws;
};

__device__ __forceinline__ int opaque_tid() { int t = threadIdx.x; asm volatile("" : "+v"(t)); return t; }
__device__ __forceinline__ float shx(float v, int m, int lane) { return __int_as_float(__builtin_amdgcn_ds_bpermute((lane ^ m) << 2, __float_as_int(v))); }
__device__ __forceinline__ float shl_(float v, int src) { return __int_as_float(__builtin_amdgcn_ds_bpermute(src << 2, __float_as_int(v))); }
__device__ __forceinline__ float softplusf_(float x) { const float e = __expf(x); return x > 20.f ? x : (e < 1e-3f ? e * (1.0f - 0.5f * e) : __logf(1.0f + e)); }
__device__ __forceinline__ unsigned pk_bf16(float lo, float hi) { unsigned r; asm("v_cvt_pk_bf16_f32 %0, %1, %2" : "=v"(r) : "v"(lo), "v"(hi)); return r; }
__device__ __forceinline__ float bf_lo(unsigned w) { return __uint_as_float(w << 16); }
__device__ __forceinline__ float bf_hi(unsigned w) { return __uint_as_float(w & 0xffff0000u); }
__device__ __forceinline__ float bf2f(bf16_t b) { return __uint_as_float(((unsigned)b) << 16); }
__device__ __forceinline__ float sigmoidf_(float x) { return __builtin_amdgcn_rcpf(1.0f + __expf(-x)); }
__device__ __forceinline__ float siluf_(float x) { return x * sigmoidf_(x); }

namespace pg8 {
constexpr int BM = 256, BK = 64, HALF = 128, HTB = HALF * BK * 2, NXCD = 8, WGM = 8;
__device__ __forceinline__ int lds_byte(int r, int c) { const int st = (r >> 4) * 2 + (c >> 5), rr = r & 15, cc = c & 31, ob = rr * 64 + cc * 2; return st * 1024 + (ob ^ (((ob >> 9) & 1) << 5)); }
__device__ __forceinline__ void stage_rc(int b, int& R, int& C) { const int st = b / 1024, sb = b % 1024, swz = sb ^ (((sb >> 9) & 1) << 5); R = (st >> 1) * 16 + swz / 64; C = (st & 1) * 32 + (swz % 64) / 2; }
__device__ __forceinline__ int perm32(int rho) { const int n = rho >> 4, i = rho & 15; return 8 * (i >> 2) + 4 * n + (i & 3); }
struct Unit { int pm, pn; };
struct Gemm { const bf16_t* A; const bf16_t* Bt; int M, N, K; };
struct StaticOrder {
    int nM, nN, nwg, G, c;
    __device__ void init(int M, int N, int G_, int c_) { nM = M / BM; nN = N / BM; nwg = nM * nN; G = G_; c = c_; }
    __device__ bool next(int i, Unit& u) const {
        const long L = (long)i * G + c; if (L >= nwg) return false;
        int wgid = (int)L; { const int q = nwg / NXCD, r = nwg % NXCD, xcd = wgid % NXCD, off = wgid / NXCD; wgid = (xcd < r ? xcd * (q + 1) : r * (q + 1) + (xcd - r) * q) + off; }
        const int nig = WGM * nN, gid = wgid / nig, fm = gid * WGM, gsz = (nM - fm) < WGM ? (nM - fm) : WGM;
        u.pm = fm + ((wgid % nig) % gsz); u.pn = (wgid % nig) / gsz; return true;
    }
};

template <class Epi>
__device__ __forceinline__ void gemm_phase(LAS unsigned char* lds, const Gemm g, const StaticOrder& S, const Epi& E) {
    const int tid = opaque_tid(), wid = __builtin_amdgcn_readfirstlane(tid >> 6), lane = tid & 63, wr = wid >> 2, wc = wid & 3, fr = lane & 15, fq = lane >> 4;
    const int K = g.K, nt = K / BK;
    unsigned voffA[2], voffB[2];
#pragma unroll
    for (int i = 0; i < 2; ++i) { int R, C; stage_rc(tid * 16 + i * 8192, R, C); const int Rb = Epi::PERM ? ((R & ~31) + perm32(R & 31)) : R;
        voffA[i] = (unsigned)(R * K + C) * 2u; voffB[i] = (unsigned)(Rb * K + C) * 2u; }
    const size_t kstep = (size_t)(BK * 2);
    const size_t hstep = (size_t)HALF * K * 2;
    const size_t tstep = 2 * hstep;
    const unsigned ldsw = (unsigned)wid * 1024u;
    const int aoff = lds_byte(wr * 64 + fr, fq * 8), boff = lds_byte(wc * 32 + fr, fq * 8);
#define PG8_SA(b, h) (((b) * 2 + (h)) * HTB)
#define PG8_SB(b, h) ((4 + (b) * 2 + (h)) * HTB)
#define PG8_STAGE(bufoff, gbase, voff) do { _Pragma("unroll") for (int _i = 0; _i < 2; ++_i) \
        __builtin_amdgcn_global_load_lds((const unsigned*)((const char*)(gbase) + (voff)[_i]), (LAS unsigned*)(lds + (bufoff) + ldsw + _i * 8192), 16, 0, 0); } while (0)
#define PG8_LDA(dst, b, h) do { _Pragma("unroll") for (int m = 0; m < 4; ++m) _Pragma("unroll") for (int k = 0; k < 2; ++k) dst[m][k] = *(const LAS bf16x8*)(lds + PG8_SA(b, h) + aoff + m * 2048 + k * 1024); } while (0)
#define PG8_LDB(dst, b, h) do { _Pragma("unroll") for (int n = 0; n < 2; ++n) _Pragma("unroll") for (int k = 0; k < 2; ++k) dst[n][k] = *(const LAS bf16x8*)(lds + PG8_SB(b, h) + boff + n * 2048 + k * 1024); } while (0)
#define PG8_MMA(ai, bj, At, Bt) do { __builtin_amdgcn_s_setprio(1); _Pragma("unroll") for (int m = 0; m < 4; ++m) _Pragma("unroll") for (int n = 0; n < 2; ++n) _Pragma("unroll") for (int k = 0; k < 2; ++k) \
        acc[ai][bj][m][n] = __builtin_amdgcn_mfma_f32_16x16x32_bf16(Bt[n][k], At[m][k], acc[ai][bj][m][n], 0, 0, 0); __builtin_amdgcn_s_setprio(0); } while (0)
#define PG8_WAIT_V(n) asm volatile("s_waitcnt vmcnt(" #n ")" ::: "memory")
#define PG8_WAIT_L(n) asm volatile("s_waitcnt lgkmcnt(" #n ")" ::: "memory")
#define PG8_BAR __builtin_amdgcn_s_barrier()
#define PG8_SCHED __builtin_amdgcn_sched_barrier(0)
    Unit cur, nxt; int ui = 0;
    if (!S.next(0, cur)) return;
    f32x4 acc[2][2][4][2];
#pragma unroll
    for (int a = 0; a < 2; ++a)
#pragma unroll
        for (int b = 0; b < 2; ++b)
#pragma unroll
            for (int m = 0; m < 4; ++m)
#pragma unroll
                for (int n = 0; n < 2; ++n) acc[a][b][m][n] = (f32x4){0.f, 0.f, 0.f, 0.f};
    bf16x8 At[4][2], B0[2][2], B1[2][2];
    const char* cA = (const char*)g.A + (size_t)cur.pm * tstep; const char* cB = (const char*)g.Bt + (size_t)cur.pn * tstep;
    PG8_STAGE(PG8_SB(0, 0), cB, voffB); PG8_STAGE(PG8_SA(0, 0), cA, voffA); PG8_STAGE(PG8_SB(0, 1), cB + hstep, voffB); PG8_STAGE(PG8_SA(0, 1), cA + hstep, voffA);
    if (wr == 1) PG8_BAR;
    PG8_WAIT_V(4); PG8_BAR;
    PG8_STAGE(PG8_SB(1, 0), cB + kstep, voffB); PG8_STAGE(PG8_SA(1, 0), cA + kstep, voffA); PG8_STAGE(PG8_SB(1, 1), cB + hstep + kstep, voffB);
    PG8_WAIT_V(6); PG8_BAR;
    for (;;) {
        const bool has_next = S.next(ui + 1, nxt);
        const char* nA = has_next ? (const char*)g.A + (size_t)nxt.pm * tstep : cA; const char* nB = has_next ? (const char*)g.Bt + (size_t)nxt.pn * tstep : cB;
        for (int t = 0; t < nt; t += 2) {
            const bool last = (t == nt - 2);
            const char* a1 = cA + (size_t)(t + 1) * kstep;
            const char* a2 = last ? nA : cA + (size_t)(t + 2) * kstep; const char* b2 = last ? nB : cB + (size_t)(t + 2) * kstep;
            const char* a3 = a2 + kstep; const char* b3 = b2 + kstep;
            PG8_LDB(B0, 0, 0); PG8_SCHED; PG8_LDA(At, 0, 0); PG8_STAGE(PG8_SA(1, 1), a1 + hstep, voffA);
            PG8_WAIT_L(8); PG8_BAR; PG8_WAIT_L(0); PG8_MMA(0, 0, At, B0); PG8_BAR; PG8_SCHED;
            PG8_LDB(B1, 0, 1); PG8_STAGE(PG8_SB(0, 0), b2, voffB);
            PG8_BAR; PG8_WAIT_L(0); PG8_MMA(0, 1, At, B1); PG8_BAR;
            PG8_LDA(At, 0, 1); PG8_STAGE(PG8_SA(0, 0), a2, voffA);
            PG8_BAR; PG8_WAIT_L(0); PG8_MMA(1, 0, At, B0); PG8_BAR; PG8_SCHED;
            PG8_STAGE(PG8_SB(0, 1), b2 + hstep, voffB);
            PG8_WAIT_V(6); PG8_BAR; PG8_MMA(1, 1, At, B1); PG8_BAR;
            PG8_LDB(B0, 1, 0); PG8_SCHED; PG8_LDA(At, 1, 0); PG8_STAGE(PG8_SA(0, 1), a2 + hstep, voffA);
            PG8_WAIT_L(8); PG8_BAR; PG8_WAIT_L(0); PG8_MMA(0, 0, At, B0); PG8_BAR; PG8_SCHED;
            PG8_LDB(B1, 1, 1); PG8_STAGE(PG8_SB(1, 0), b3, voffB);
            PG8_BAR; PG8_WAIT_L(0); PG8_MMA(0, 1, At, B1); PG8_BAR;
            PG8_LDA(At, 1, 1); PG8_STAGE(PG8_SA(1, 0), a3, voffA);
            PG8_BAR; PG8_WAIT_L(0); PG8_MMA(1, 0, At, B0); PG8_BAR; PG8_SCHED;
            PG8_STAGE(PG8_SB(1, 1), b3 + hstep, voffB);
            PG8_WAIT_V(6); PG8_BAR; PG8_MMA(1, 1, At, B1); PG8_BAR;
        }
        E(acc, cur, wr, wc, fr, fq);
        if (!has_next) break;
#pragma unroll
        for (int a = 0; a < 2; ++a)
#pragma unroll
            for (int b = 0; b < 2; ++b)
#pragma unroll
                for (int m = 0; m < 4; ++m)
#pragma unroll
                    for (int n = 0; n < 2; ++n) acc[a][b][m][n] = (f32x4){0.f, 0.f, 0.f, 0.f};
        cur = nxt; cA = nA; cB = nB; ++ui;
    }
    PG8_WAIT_V(0);
    if (wr == 0) PG8_BAR;
    PG8_BAR;
#undef PG8_SA
#undef PG8_SB
#undef PG8_STAGE
#undef PG8_LDA
#undef PG8_LDB
#undef PG8_MMA
#undef PG8_WAIT_V
#undef PG8_WAIT_L
#undef PG8_BAR
#undef PG8_SCHED
}
}
using pg8::Unit;

struct EpiResid {
    static constexpr bool PERM = false;
    const float* res0; const float* res1; int split_row; float* out; float s;
    __device__ __forceinline__ void operator()(const f32x4 (&acc)[2][2][4][2], const Unit& u, int wr, int wc, int fr, int fq) const {
        const int row0 = u.pm * 256 + wr * 64 + fr, col0 = u.pn * 256 + wc * 32 + 4 * fq;
#pragma unroll
        for (int ai = 0; ai < 2; ++ai)
#pragma unroll
            for (int m = 0; m < 4; ++m) {
                const int row = row0 + ai * 128 + m * 16;
                const float* rp = (row < split_row) ? res0 + (size_t)row * DM : res1 + (size_t)(row - split_row) * DM;
                float* op = out + (size_t)row * DM;
#pragma unroll
                for (int bj = 0; bj < 2; ++bj)
#pragma unroll
                    for (int n = 0; n < 2; ++n) { const int c = col0 + bj * 128 + n * 16; const f32x4 r = *(const f32x4*)(rp + c); *(f32x4*)(op + c) = r * ALPHA + acc[ai][bj][m][n] * s; }
            }
    }
};
struct EpiBf {
    static constexpr bool PERM = true;
    int mode;
    bf16_t* O; const bf16_t* O2; const float* bias; unsigned char* reg;
    __device__ __forceinline__ void operator()(const f32x4 (&acc)[2][2][4][2], const Unit& u, int wr, int wc, int fr, int fq) const {
        const int row0 = u.pm * 256 + wr * 64 + fr;
        if (mode == 0) {
            const int col0 = u.pn * 128 + wc * 32 + 8 * fq;
#pragma unroll
            for (int ai = 0; ai < 2; ++ai)
#pragma unroll
                for (int m = 0; m < 4; ++m) {
                    const int row = row0 + ai * 128 + m * 16;
                    const f32x4 g0 = acc[ai][0][m][0], g1 = acc[ai][0][m][1], u0 = acc[ai][1][m][0], u1 = acc[ai][1][m][1];
                    u32x4 w; w.x = pk_bf16(siluf_(g0[0]) * u0[0], siluf_(g0[1]) * u0[1]); w.y = pk_bf16(siluf_(g0[2]) * u0[2], siluf_(g0[3]) * u0[3]);
                    w.z = pk_bf16(siluf_(g1[0]) * u1[0], siluf_(g1[1]) * u1[1]); w.w = pk_bf16(siluf_(g1[2]) * u1[2], siluf_(g1[3]) * u1[3]);
                    *(u32x4*)(O + (size_t)row * DFF + col0) = w;
                }
        } else if (mode == 1) {
#pragma unroll
            for (int bj = 0; bj < 2; ++bj) {
                const int c0 = u.pn * 256 + bj * 128 + wc * 32 + 8 * fq;
                if (c0 >= 2848) continue;
                if (c0 >= 2816) {
                    float* ab = (float*)(reg + R_AB);
#pragma unroll
                    for (int ai = 0; ai < 2; ++ai)
#pragma unroll
                        for (int m = 0; m < 4; ++m) { const int row = row0 + ai * 128 + m * 16; float* q = ab + (size_t)row * 32 + (c0 - 2816); *(f32x4*)q = acc[ai][bj][m][0]; *(f32x4*)(q + 4) = acc[ai][bj][m][1]; }
                    continue;
                }
                bf16_t* bp; int ld;
                if (c0 < 512) { bp = (bf16_t*)(reg + R_AQ) + c0; ld = 512; }
                else if (c0 < 768) { bp = (bf16_t*)(reg + R_AKV) + (c0 - 512); ld = 256; }
                else if (c0 < 2304) { bp = (bf16_t*)(reg + R_DNR) + (c0 - 768); ld = 1536; }
                else { bp = (bf16_t*)(reg + R_Z) + (c0 - 2304); ld = 512; }
#pragma unroll
                for (int ai = 0; ai < 2; ++ai)
#pragma unroll
                    for (int m = 0; m < 4; ++m) { const int row = row0 + ai * 128 + m * 16; const f32x4 v0 = acc[ai][bj][m][0], v1 = acc[ai][bj][m][1];
                        u32x4 w; w.x = pk_bf16(v0[0], v0[1]); w.y = pk_bf16(v0[2], v0[3]); w.z = pk_bf16(v1[0], v1[1]); w.w = pk_bf16(v1[2], v1[3]);
                        *(u32x4*)(bp + (size_t)row * ld) = w; }
            }
        } else {
#pragma unroll
            for (int bj = 0; bj < 2; ++bj) {
                const int c0 = u.pn * 256 + bj * 128 + wc * 32 + 8 * fq;
                f32x4 b0 = (f32x4){0.f, 0.f, 0.f, 0.f}, b1 = b0;
                if (mode >= 3) { b0 = *(const f32x4*)(bias + c0); b1 = *(const f32x4*)(bias + c0 + 4); }
#pragma unroll
                for (int ai = 0; ai < 2; ++ai)
#pragma unroll
                    for (int m = 0; m < 4; ++m) { const int row = row0 + ai * 128 + m * 16; f32x4 v0 = acc[ai][bj][m][0], v1 = acc[ai][bj][m][1];
                        bf16_t* op = O + (size_t)row * DM + c0;
                        if (mode >= 3) {
                            const u32x4 o = *(const u32x4*)op;
                            f32x4 p0 = (f32x4){bf_lo(o.x), bf_hi(o.x), bf_lo(o.y), bf_hi(o.y)}, p1 = (f32x4){bf_lo(o.z), bf_hi(o.z), bf_lo(o.w), bf_hi(o.w)};
#pragma unroll
                            for (int j = 0; j < 4; ++j) { v0[j] = sigmoidf_(v0[j] + b0[j]); v1[j] = sigmoidf_(v1[j] + b1[j]); }
                            if (mode == 3) { v0 = v0 * p0; v1 = v1 * p1; }
                            else { const u32x4 o2 = *(const u32x4*)(O2 + (size_t)row * DM + c0);
                                const f32x4 q0 = (f32x4){bf_lo(o2.x), bf_hi(o2.x), bf_lo(o2.y), bf_hi(o2.y)}, q1 = (f32x4){bf_lo(o2.z), bf_hi(o2.z), bf_lo(o2.w), bf_hi(o2.w)};
                                v0 = p0 + v0 * q0; v1 = p1 + v1 * q1; }
                        }
                        u32x4 w; w.x = pk_bf16(v0[0], v0[1]); w.y = pk_bf16(v0[2], v0[3]); w.z = pk_bf16(v1[0], v1[1]); w.w = pk_bf16(v1[2], v1[3]);
                        *(u32x4*)op = w; }
            }
        }
    }
};

__device__ __forceinline__ void cvt_tile(LAS float* tile, const float* src, int ldsrc, int ncols_valid, float scale, bf16_t* dst, int lddst) {
    const int tid = opaque_tid();
#pragma unroll
    for (int e = 0; e < 8; ++e) { const int idx = tid + e * 512, kk = idx >> 6, cc = idx & 63; tile[kk * 65 + cc] = (cc < ncols_valid) ? src[(size_t)kk * ldsrc + cc] * scale : 0.f; }
    __syncthreads();
#pragma unroll
    for (int e = 0; e < 4; ++e) { const int idx = tid + e * 512, rr = idx >> 5, kp = idx & 31; *(unsigned*)(dst + (size_t)rr * lddst + 2 * kp) = pk_bf16(tile[(2 * kp) * 65 + rr], tile[(2 * kp + 1) * 65 + rr]); }
    __syncthreads();
}
__device__ __forceinline__ void cvt_plain(LAS float* tile, int t, const float* src, bf16_t* dst, int K, int Nsrc, int qscale_rows) {
    const int nk = K / 64, rb = t / nk, kb = t % nk, r0 = rb * 64, k0 = kb * 64;
    int nv = Nsrc - r0; nv = nv > 64 ? 64 : (nv < 0 ? 0 : nv);
    cvt_tile(tile, src + (size_t)k0 * Nsrc + r0, Nsrc, nv, r0 < qscale_rows ? 0.125f : 1.0f, dst + (size_t)r0 * K + k0, K);
}
__device__ void phase_convert(const P& p, LAS unsigned char* lds) {
    LAS float* tile = (LAS float*)lds;
    bf16_t* W = (bf16_t*)p.ws;
    const int G = gridDim.x;
    for (int t = blockIdx.x; t < 12032; t += G) {
        const int l = t / 6016; int r = t % 6016;
        bf16_t* Wl = W + (size_t)l * W_LAYER;
        if (r < 2816) {
            const int f = r / 1408; r %= 1408; const int rb = r / 16, kb = r % 16, r0 = rb * 64, k0 = kb * 64;
            const int pn = r0 >> 8, x = r0 & 255;
            const float* src = (x < 128 ? p.w_fg : p.w_fu) + (size_t)(l * 2 + f) * DM * DFF + (size_t)k0 * DFF + pn * 128 + (x & 127);
            cvt_tile(tile, src, DFF, 64, 1.0f, Wl + (f ? W_GU1 : W_GU0) + (size_t)r0 * DM + k0, DM);
        } else if (r < 4224) {
            r -= 2816; const int f = r / 704; r %= 704;
            cvt_plain(tile, r, p.w_fd + (size_t)(l * 2 + f) * DFF * DM, Wl + (f ? W_D1 : W_D0), DFF, DM, 0);
        } else if (r < 4992) { cvt_plain(tile, r - 4224, p.w_in + (size_t)l * DM * 2848, Wl + W_PR, DM, 2848, 512); }
        else if (r < 5504) { cvt_plain(tile, r - 4992, p.w_gate + (size_t)l * DM * 2048, Wl + W_GT, DM, 2048, 0); }
        else if (r < 5632) { cvt_plain(tile, r - 5504, p.w_att + (size_t)l * 512 * DM, Wl + W_AT, 512, DM, 0); }
        else if (r < 5760) { cvt_plain(tile, r - 5632, p.w_dn + (size_t)l * 512 * DM, Wl + W_DN, 512, DM, 0); }
        else { cvt_plain(tile, r - 5760, p.w_o + (size_t)l * DM * DM, Wl + W_WO, DM, DM, 0); }
    }
    bf16_t* xb = (bf16_t*)(p.ws + XB_OFF);
    const size_t n8 = (size_t)T_TOK * DM / 8, split8 = (size_t)T_PROMPT * DM / 8;
    for (size_t i = (size_t)blockIdx.x * 512 + opaque_tid(); i < n8; i += (size_t)G * 512) {
        const float* s = (i < split8) ? p.x_prompt + i * 8 : p.x_sample + (i - split8) * 8;
        const f32x4 a = *(const f32x4*)s, b = *(const f32x4*)(s + 4);
        u32x4 w; w.x = pk_bf16(a[0], a[1]); w.y = pk_bf16(a[2], a[3]); w.z = pk_bf16(b[0], b[1]); w.w = pk_bf16(b[2], b[3]);
        *(u32x4*)(xb + i * 8) = w;
    }
}

__device__ __forceinline__ float wave_sum(float v, int lane) {
    v += shx(v, 32, lane); v += shx(v, 16, lane); v += shx(v, 8, lane); v += shx(v, 4, lane); v += shx(v, 2, lane); v += shx(v, 1, lane); return v;
}
__device__ void phase_ln(const P& p, int lnidx) {
    const int tid_ = opaque_tid(), wid = tid_ >> 6, lane = tid_ & 63;
    const float* g = p.ln_g + (size_t)lnidx * DM; const float* b = p.ln_b + (size_t)lnidx * DM;
    bf16_t* xb = (bf16_t*)(p.ws + XB_OFF);
    f32x4 gv[4], bv[4];
#pragma unroll
    for (int i = 0; i < 4; ++i) { gv[i] = *(const f32x4*)(g + i * 256 + lane * 4); bv[i] = *(const f32x4*)(b + i * 256 + lane * 4); }
    for (int row = blockIdx.x * 8 + wid; row < T_TOK; row += gridDim.x * 8) {
        float* xp = p.out + (size_t)row * DM;
        f32x4 v[4]; float s = 0.f;
#pragma unroll
        for (int i = 0; i < 4; ++i) { v[i] = *(const f32x4*)(xp + i * 256 + lane * 4); s += (v[i][0] + v[i][1]) + (v[i][2] + v[i][3]); }
        const float mean = wave_sum(s, lane) * (1.0f / 1024.0f);
        float q = 0.f;
#pragma unroll
        for (int i = 0; i < 4; ++i) { const f32x4 d = v[i] - mean; q += (d[0] * d[0] + d[1] * d[1]) + (d[2] * d[2] + d[3] * d[3]); }
        const float rstd = rsqrtf(wave_sum(q, lane) * (1.0f / 1024.0f) + 1e-5f);
#pragma unroll
        for (int i = 0; i < 4; ++i) {
            const f32x4 y = (v[i] - mean) * rstd * gv[i] + bv[i];
            *(f32x4*)(xp + i * 256 + lane * 4) = y;
            u32x2 w; w.x = pk_bf16(y[0], y[1]); w.y = pk_bf16(y[2], y[3]);
            *(u32x2*)(xb + (size_t)row * DM + i * 256 + lane * 4) = w;
        }
    }
}

__device__ __forceinline__ int t5_bucket(int rel) {
    const int n = rel < 0 ? -rel : rel;
    const int b = n < 8 ? n : n < 12 ? 8 : n < 16 ? 9 : n < 23 ? 10 : n < 32 ? 11 : n < 46 ? 12 : n < 64 ? 13 : n < 91 ? 14 : 15;
    return b + (rel > 0 ? 16 : 0);
}
constexpr int AT_KS = 0, AT_VT = 55296, AT_TB = 104960;
__device__ void attn_item(const P& p, int layer, int item, LAS unsigned char* lds) {
    const int tid = opaque_tid(), wid = tid >> 6, lane = tid & 63;
    const int kvh = item & 1, nb = (item >> 1) & 63, s = item >> 7;
    unsigned char* reg = p.ws + REG_OFF;
    bf16_t* AQ = (bf16_t*)(reg + R_AQ); const bf16_t* AKV = (const bf16_t*)(reg + R_AKV);
    LAS float* tb = (LAS float*)(lds + AT_TB);
    for (int c = tid; c < 3072; c += 512) {
        const int j = c >> 3, dc = c & 7, pos = nb * 128 - 128 + j;
        u32x4 kv = (u32x4){0u, 0u, 0u, 0u}, vv = kv;
        if (pos >= 0 && pos < SEQ) { const bf16_t* rp = AKV + (size_t)(s * SEQ + pos) * 256 + kvh * 64 + dc * 8; kv = *(const u32x4*)rp; vv = *(const u32x4*)(rp + 128); }
        *(LAS u32x4*)(lds + AT_KS + j * 144 + dc * 16) = kv;
        LAS bf16_t* vt = (LAS bf16_t*)(lds + AT_VT) + (dc * 8) * 388 + j;
        vt[0 * 388] = (bf16_t)(vv.x & 0xffffu); vt[1 * 388] = (bf16_t)(vv.x >> 16); vt[2 * 388] = (bf16_t)(vv.y & 0xffffu); vt[3 * 388] = (bf16_t)(vv.y >> 16);
        vt[4 * 388] = (bf16_t)(vv.z & 0xffffu); vt[5 * 388] = (bf16_t)(vv.z >> 16); vt[6 * 388] = (bf16_t)(vv.w & 0xffffu); vt[7 * 388] = (bf16_t)(vv.w >> 16);
    }
    for (int i = tid; i < 4 * 257; i += 512) { const int g = i / 257, r = i % 257; tb[g * 260 + r] = p.rel_bias[t5_bucket(r - 128) * 8 + kvh * 4 + g]; }
    __syncthreads();
    const int n = lane & 31, h = lane >> 5;
#pragma unroll 1
    for (int pp = 0; pp < 2; ++pp) {
        const int pair = wid + 8 * pp, g = pair & 3, qs = pair >> 2, hq = kvh * 4 + g, i = 32 * qs + n;
        bf16_t* qrow = AQ + (size_t)(s * SEQ + nb * 128 + i) * 512 + hq * 64;
        bf16x8 qf[4];
#pragma unroll
        for (int ks = 0; ks < 4; ++ks) qf[ks] = *(const bf16x8*)(qrow + 16 * ks + 8 * h);
        float m_run = p.sink[layer * 8 + hq], l_run = (h == 0) ? 1.0f : 0.0f;
        f32x16 o0, o1;
#pragma unroll
        for (int r = 0; r < 16; ++r) { o0[r] = 0.f; o1[r] = 0.f; }
#pragma unroll 1
        for (int kt = qs; kt <= qs + 8; ++kt) {
            f32x16 sa;
#pragma unroll
            for (int r = 0; r < 16; ++r) sa[r] = 0.f;
#pragma unroll
            for (int ks = 0; ks < 4; ++ks) { const bf16x8 kf = *(const LAS bf16x8*)(lds + AT_KS + (32 * kt + n) * 144 + (16 * ks + 8 * h) * 2); sa = __builtin_amdgcn_mfma_f32_32x32x16_bf16(kf, qf[ks], sa, 0, 0, 0); }
            float mx = m_run;
#pragma unroll
            for (int r = 0; r < 16; ++r) {
                const int kr = (r & 3) + 8 * (r >> 2) + 4 * h, j = 32 * kt + kr, rel = j - 128 - i, pos = nb * 128 - 128 + j;
                const bool valid = (rel >= -128) && (rel <= 128) && (pos >= 0) && (pos < SEQ);
                int ri = rel + 128; ri = ri < 0 ? 0 : (ri > 256 ? 256 : ri);
                const float v = valid ? sa[r] + tb[g * 260 + ri] : -1e30f;
                sa[r] = v; mx = fmaxf(mx, v);
            }
            mx = fmaxf(mx, shx(mx, 32, lane));
            const float corr = __expf(m_run - mx); m_run = mx;
            float ps = 0.f;
#pragma unroll
            for (int r = 0; r < 16; ++r) { const float e = __expf(sa[r] - mx); sa[r] = e; ps += e; }
            l_run = l_run * corr + ps;
#pragma unroll
            for (int r = 0; r < 16; ++r) { o0[r] *= corr; o1[r] *= corr; }
#pragma unroll
            for (int s2 = 0; s2 < 2; ++s2) {
                u32x4 pw; pw.x = pk_bf16(sa[8 * s2 + 0], sa[8 * s2 + 1]); pw.y = pk_bf16(sa[8 * s2 + 2], sa[8 * s2 + 3]); pw.z = pk_bf16(sa[8 * s2 + 4], sa[8 * s2 + 5]); pw.w = pk_bf16(sa[8 * s2 + 6], sa[8 * s2 + 7]);
                const bf16x8 pf = __builtin_bit_cast(bf16x8, pw);
                const int jb = 32 * kt + 16 * s2 + 4 * h;
#pragma unroll
                for (int dt = 0; dt < 2; ++dt) {
                    const LAS unsigned char* vp = lds + AT_VT + (32 * dt + n) * 776 + jb * 2;
                    const u32x2 lo = *(const LAS u32x2*)vp, hi = *(const LAS u32x2*)(vp + 16);
                    const u32x4 vw = (u32x4){lo.x, lo.y, hi.x, hi.y};
                    const bf16x8 vf = __builtin_bit_cast(bf16x8, vw);
                    if (dt == 0) o0 = __builtin_amdgcn_mfma_f32_32x32x16_bf16(vf, pf, o0, 0, 0, 0); else o1 = __builtin_amdgcn_mfma_f32_32x32x16_bf16(vf, pf, o1, 0, 0, 0);
                }
            }
        }
        const float inv = 1.0f / (l_run + shx(l_run, 32, lane));
#pragma unroll
        for (int a = 0; a < 4; ++a) {
            u32x2 w0, w1;
            w0.x = pk_bf16(o0[4 * a] * inv, o0[4 * a + 1] * inv); w0.y = pk_bf16(o0[4 * a + 2] * inv, o0[4 * a + 3] * inv);
            w1.x = pk_bf16(o1[4 * a] * inv, o1[4 * a + 1] * inv); w1.y = pk_bf16(o1[4 * a + 2] * inv, o1[4 * a + 3] * inv);
            *(u32x2*)(qrow + 8 * a + 4 * h) = w0; *(u32x2*)(qrow + 32 + 8 * a + 4 * h) = w1;
        }
    }
    __syncthreads();
}

constexpr int G_QS = 0, G_KS = 18432, G_VS = 36864, G_ATT = 53248, G_KT = 71680, G_AM = 90112, G_DD = 106496, G_UU = 122880, G_SC = 132096, G_CW = 136448;
__device__ __forceinline__ bf16x8 pack8(const f32x16& v, int o) {
    u32x4 w; w.x = pk_bf16(v[o + 0], v[o + 1]); w.y = pk_bf16(v[o + 2], v[o + 3]); w.z = pk_bf16(v[o + 4], v[o + 5]); w.w = pk_bf16(v[o + 6], v[o + 7]); return __builtin_bit_cast(bf16x8, w);
}
__device__ __forceinline__ bf16x8 pack8lo(const f32x16& v, int o) {
    float r[8];
#pragma unroll
    for (int e = 0; e < 8; e += 2) { const unsigned hp = pk_bf16(v[o + e], v[o + e + 1]); r[e] = v[o + e] - bf_lo(hp); r[e + 1] = v[o + e + 1] - bf_hi(hp); }
    u32x4 w; w.x = pk_bf16(r[0], r[1]); w.y = pk_bf16(r[2], r[3]); w.z = pk_bf16(r[4], r[5]); w.w = pk_bf16(r[6], r[7]); return __builtin_bit_cast(bf16x8, w);
}
#define MFMA32(a, b, c) __builtin_amdgcn_mfma_f32_32x32x16_bf16((a), (b), (c), 0, 0, 0)
__device__ void gdn_chain(const P& p, int layer, int chain, LAS unsigned char* lds) {
    const int tid = opaque_tid(), wid = tid >> 6, lane = tid & 63;
    const int hd = chain & 7, dir = (chain >> 3) & 1, s = chain >> 4;
    unsigned char* reg = p.ws + REG_OFF;
    const bf16_t* DNR = (const bf16_t*)(reg + R_DNR) + (size_t)s * SEQ * 1536;
    const float* AB = (const float*)(reg + R_AB) + (size_t)s * SEQ * 32 + dir * 8 + hd;
    bf16_t* OUT = (bf16_t*)(reg + (dir ? R_OB : R_OF)) + (size_t)s * SEQ * 512 + hd * 64;
    LAS float* SC = (LAS float*)(lds + G_SC);
    LAS float* glv = SC + 1024;
    LAS float* Am = (LAS float*)(lds + G_AM); LAS float* DD = (LAS float*)(lds + G_DD); LAS bf16_t* UU = (LAS bf16_t*)(lds + G_UU);
    LAS float* CW = (LAS float*)(lds + G_CW);
    for (int i = tid; i < 576; i += 512) { const int tap = i / 192, c = i % 192; CW[i] = p.conv[(size_t)layer * 3 * 1536 + tap * 1536 + (c >> 6) * 512 + hd * 64 + (c & 63)]; }
    const int jid = tid >= 320 ? tid - 320 : 0, cgi = jid % 24, st = jid / 24, part = cgi >> 3, col8 = (cgi & 7) * 8;
    const float neg_ea = -__expf(p.a_log[layer * 16 + dir * 8 + hd]), dtb = p.dt_bias[layer * 16 + dir * 8 + hd];
#define GDN_LOAD(nc_) do { const int oc_ = dir ? 127 - (nc_) : (nc_); \
        if (wid >= 5) { _Pragma("unroll") for (int i_ = 0; i_ < 10; ++i_) { const int pos_ = oc_ * 64 + 8 * st - 1 + i_; const bool ok_ = (pos_ >= 0) && (pos_ < SEQ); \
            raw[i_] = ok_ ? *(const u32x4*)(DNR + (size_t)pos_ * 1536 + part * 512 + hd * 64 + col8) : (u32x4){0u, 0u, 0u, 0u}; } } \
        else if (wid == 4) { const float* ap_ = AB + (size_t)(oc_ * 64 + lane) * 32; av = ap_[0]; btv = ap_[16]; } } while (0)
    f32x16 S0, S1, oq0, oq1;
#pragma unroll
    for (int r = 0; r < 16; ++r) { S0[r] = 0.f; S1[r] = 0.f; oq0[r] = 0.f; oq1[r] = 0.f; }
    __syncthreads();
#pragma unroll 1
    for (int c = -2; c <= 128; ++c) {
        if (wid >= 4) {
            if (c >= 0 && c < 128) {
                int tl = lane; asm volatile("" : "+v"(tl));
                const int mi = (wid >> 1) & 1, nj = wid & 1, n = tl & 31, h = tl >> 5;
                if (!(mi == 0 && nj == 1)) {
                    const LAS bf16_t* ksr = (const LAS bf16_t*)(lds + G_KS + (c & 1) * 9216);
                    const LAS float* scb = SC + (c & 3) * 256;
                    f32x16 kkacc;
#pragma unroll
                    for (int r = 0; r < 16; ++r) kkacc[r] = 0.f;
#pragma unroll
                    for (int k4 = 0; k4 < 4; ++k4)
                        kkacc = MFMA32(*(const LAS bf16x8*)(ksr + (32 * mi + n) * 72 + 16 * k4 + 8 * h), *(const LAS bf16x8*)(ksr + (32 * nj + n) * 72 + 16 * k4 + 8 * h), kkacc);
                    const int jp = 32 * nj + n; const float gj = scb[jp];
#pragma unroll
                    for (int r = 0; r < 16; ++r) {
                        const int ip = 32 * mi + (r & 3) + 8 * (r >> 2) + 4 * h;
                        const float e = __expf(fminf(scb[ip] - gj, 0.f));
                        Am[ip * 64 + jp] = (ip > jp) ? scb[64 + ip] * kkacc[r] * e : 0.f;
                    }
                }
            }
        } else if (wid >= 2) {
            int tl = lane; asm volatile("" : "+v"(tl));
            const int nw = wid - 2, n = tl & 31, h = tl >> 5;
#define GDN_FR(base, row, kcol) (*(const LAS bf16x8*)((base) + (row) * 72 + (kcol) + 8 * h))
            if (c >= 1) {
                const int pc = c - 1;
                const LAS bf16_t* att = (const LAS bf16_t*)(lds + G_ATT + (pc & 1) * 9216); const LAS bf16_t* kt = (const LAS bf16_t*)(lds + G_KT + (pc & 1) * 9216);
                const LAS float* ED = SC + (pc & 3) * 256 + 192;
                const float gl = glv[pc & 3];
#pragma unroll
                for (int r = 0; r < 16; ++r) { S0[r] *= gl; S1[r] *= gl; }
#pragma unroll
                for (int kk = 0; kk < 4; ++kk) {
                    const bf16x8 uf = *(const LAS bf16x8*)(UU + (32 * nw + n) * 72 + 16 * kk + 8 * h);
                    const f32x4 e0 = *(const LAS f32x4*)(ED + 16 * kk + 8 * h), e1 = *(const LAS f32x4*)(ED + 16 * kk + 8 * h + 4);
                    const u32x4 uw = __builtin_bit_cast(u32x4, uf);
                    u32x4 sw; sw.x = pk_bf16(bf_lo(uw.x) * e0[0], bf_hi(uw.x) * e0[1]); sw.y = pk_bf16(bf_lo(uw.y) * e0[2], bf_hi(uw.y) * e0[3]);
                    sw.z = pk_bf16(bf_lo(uw.z) * e1[0], bf_hi(uw.z) * e1[1]); sw.w = pk_bf16(bf_lo(uw.w) * e1[2], bf_hi(uw.w) * e1[3]);
                    const bf16x8 ub = __builtin_bit_cast(bf16x8, sw);
                    if (kk < 2) oq0 = MFMA32(GDN_FR(att, n, 16 * kk), uf, oq0);
                    oq1 = MFMA32(GDN_FR(att, 32 + n, 16 * kk), uf, oq1);
                    S0 = MFMA32(GDN_FR(kt, n, 16 * kk), ub, S0); S1 = MFMA32(GDN_FR(kt, 32 + n, 16 * kk), ub, S1);
                    __builtin_amdgcn_sched_barrier(0);
                }
                const int oc = dir ? 127 - pc : pc; const int ostr = dir ? -512 : 512;
                bf16_t* ob = OUT + ((size_t)oc * 64 + (dir ? 63 : 0)) * 512 + 32 * nw + n + (4 * h) * ostr;
#pragma unroll
                for (int r = 0; r < 16; ++r) {
                    const int ipc = (r & 3) + 8 * (r >> 2);
                    ob[ipc * ostr] = (bf16_t)(pk_bf16(oq0[r], 0.f) & 0xffffu);
                    ob[(32 + ipc) * ostr] = (bf16_t)(pk_bf16(oq1[r], 0.f) & 0xffffu);
                }
            }
            if (c >= 0 && c < 128) {
                const LAS bf16_t* ksp = (const LAS bf16_t*)(lds + G_KS + (c & 1) * 9216); const LAS bf16_t* qsp = (const LAS bf16_t*)(lds + G_QS + (c & 1) * 9216);
                const LAS bf16_t* vsp = (const LAS bf16_t*)(lds + G_VS + (c & 1) * 8192);
                const LAS float* scb = SC + (c & 3) * 256;
                f32x16 p0, p1;
#pragma unroll
                for (int r = 0; r < 16; ++r) { p0[r] = 0.f; p1[r] = 0.f; oq0[r] = 0.f; oq1[r] = 0.f; }
#pragma unroll
                for (int kk = 0; kk < 4; ++kk) {
                    const bf16x8 hh = (kk < 2) ? pack8(S0, 8 * (kk & 1)) : pack8(S1, 8 * (kk & 1));
                    const bf16x8 ll = (kk < 2) ? pack8lo(S0, 8 * (kk & 1)) : pack8lo(S1, 8 * (kk & 1));
                    const bf16x8 f0 = GDN_FR(ksp, n, 16 * kk), f1 = GDN_FR(ksp, 32 + n, 16 * kk);
                    p0 = MFMA32(f0, hh, p0); p1 = MFMA32(f1, hh, p1); p0 = MFMA32(f0, ll, p0); p1 = MFMA32(f1, ll, p1);
                    oq0 = MFMA32(GDN_FR(qsp, n, 16 * kk), hh, oq0); oq1 = MFMA32(GDN_FR(qsp, 32 + n, 16 * kk), hh, oq1);
                    __builtin_amdgcn_sched_barrier(0);
                }
#pragma unroll
                for (int r = 0; r < 16; ++r) {
                    const int i0 = (r & 3) + 8 * (r >> 2) + 4 * h, i1 = 32 + i0;
                    const float b0 = scb[64 + i0], e0 = scb[128 + i0], b1 = scb[64 + i1], e1 = scb[128 + i1];
                    DD[i0 * 64 + 32 * nw + n] = b0 * (bf2f(vsp[i0 * 64 + 32 * nw + n]) - e0 * p0[r]);
                    DD[i1 * 64 + 32 * nw + n] = b1 * (bf2f(vsp[i1 * 64 + 32 * nw + n]) - e1 * p1[r]);
                    oq0[r] *= e0; oq1[r] *= e1;
                }
            }
#undef GDN_FR
        }
        __syncthreads();
        if (wid == 0) {
            if (c >= 0 && c < 128) {
                int ln = lane; asm volatile("" : "+v"(ln));
                int zv = 0; asm volatile("" : "+v"(zv));
                const LAS float* Amz = Am + zv;
                float x[64];
#pragma unroll
                for (int i = 0; i < 64; ++i) x[i] = DD[i * 64 + ln];
                f32x4 buf[3][4];
#define SOLVE_LOAD(slot, jb_, g_) do { _Pragma("unroll") for (int q_ = 0; q_ < 4; ++q_) { const int i_ = 4 * (jb_) + 1 + 4 * (g_) + q_; if (i_ < 64) buf[slot][q_] = *(const LAS f32x4*)(Amz + i_ * 64 + 4 * (jb_)); } } while (0)
                SOLVE_LOAD(0, 0, 0); SOLVE_LOAD(1, 0, 1);
#pragma unroll
                for (int jb = 0; jb < 16; ++jb) {
#pragma unroll
                    for (int g = 0; g < 16 - jb; ++g) {
                        const int cnt = 16 * jb - (jb * (jb - 1)) / 2 + g;
                        { int jb2 = jb, g2 = g + 2; if (g2 >= 16 - jb2) { g2 -= (16 - jb2); jb2 += 1; if (jb2 < 16 && g2 >= 16 - jb2) { g2 -= (16 - jb2); jb2 += 1; } }
                          if (jb2 < 16) SOLVE_LOAD((cnt + 2) % 3, jb2, g2); }
#pragma unroll
                        for (int q = 0; q < 4; ++q) {
                            const int i = 4 * jb + 1 + 4 * g + q;
                            if (i < 64) {
                                const f32x4 ar = buf[cnt % 3][q];
#pragma unroll
                                for (int cc = 0; cc < 4; ++cc) if (4 * jb + cc < i) asm("v_fma_f32 %0, -%1, %2, %0" : "+v"(x[i]) : "v"(ar[cc]), "v"(x[4 * jb + cc]));
                            }
                        }
                        __builtin_amdgcn_sched_barrier(0);
                    }
                }
#undef SOLVE_LOAD
#pragma unroll
                for (int g8 = 0; g8 < 8; ++g8) {
                    u32x4 w; w.x = pk_bf16(x[8 * g8], x[8 * g8 + 1]); w.y = pk_bf16(x[8 * g8 + 2], x[8 * g8 + 3]); w.z = pk_bf16(x[8 * g8 + 4], x[8 * g8 + 5]); w.w = pk_bf16(x[8 * g8 + 6], x[8 * g8 + 7]);
                    *(LAS u32x4*)(UU + ln * 72 + 8 * g8) = w;
                }
            }
        } else if (wid >= 4) {
            const int c2 = c + 2, c1 = c + 1;
            if (c2 >= 0 && c2 < 128) {
                u32x4 raw[10]; float av = 0.f, btv = 0.f;
                GDN_LOAD(c2);
                if (wid >= 5) {
                    int jl = cgi; asm volatile("" : "+v"(jl));
                    int stl = st; asm volatile("" : "+v"(stl));
                    int ll = lane; asm volatile("" : "+v"(ll));
                    LAS bf16_t* qsw = (LAS bf16_t*)(lds + G_QS + (c2 & 1) * 9216); LAS bf16_t* ksw = (LAS bf16_t*)(lds + G_KS + (c2 & 1) * 9216); LAS bf16_t* vsw = (LAS bf16_t*)(lds + G_VS + (c2 & 1) * 8192);
                    const LAS float* cwp = CW + jl * 8;
                    const f32x4 wa0 = *(const LAS f32x4*)(cwp), wa1 = *(const LAS f32x4*)(cwp + 4), wb0 = *(const LAS f32x4*)(cwp + 192), wb1 = *(const LAS f32x4*)(cwp + 196), wc0 = *(const LAS f32x4*)(cwp + 384), wc1 = *(const LAS f32x4*)(cwp + 388);
                    const int g = (col8 >> 3), pb = 16 * (g >> 1) + 4 * (g & 1);
#pragma unroll
                    for (int rr = 0; rr < 8; ++rr) {
                        float cv[8];
#pragma unroll
                        for (int e2 = 0; e2 < 4; ++e2) {
                            const unsigned w0 = raw[rr][e2], w1 = raw[rr + 1][e2], w2 = raw[rr + 2][e2];
                            const float a0 = e2 < 2 ? wa0[2 * e2] : wa1[2 * e2 - 4], a1 = e2 < 2 ? wa0[2 * e2 + 1] : wa1[2 * e2 - 3];
                            const float b0 = e2 < 2 ? wb0[2 * e2] : wb1[2 * e2 - 4], b1 = e2 < 2 ? wb0[2 * e2 + 1] : wb1[2 * e2 - 3];
                            const float c0 = e2 < 2 ? wc0[2 * e2] : wc1[2 * e2 - 4], c1_ = e2 < 2 ? wc0[2 * e2 + 1] : wc1[2 * e2 - 3];
                            cv[2 * e2] = siluf_(a0 * bf_lo(w0) + b0 * bf_lo(w1) + c0 * bf_lo(w2));
                            cv[2 * e2 + 1] = siluf_(a1 * bf_hi(w0) + b1 * bf_hi(w1) + c1_ * bf_hi(w2));
                        }
                        float ss = 0.f;
#pragma unroll
                        for (int e = 0; e < 8; ++e) ss += cv[e] * cv[e];
                        ss += shx(ss, 1, ll); ss += shx(ss, 2, ll); ss += shx(ss, 4, ll);
                        const float sc = part == 0 ? rsqrtf(ss + 1e-6f) * 0.125f : (part == 1 ? rsqrtf(ss + 1e-6f) : 1.0f);
                        u32x2 wl, wh; wl.x = pk_bf16(cv[0] * sc, cv[1] * sc); wl.y = pk_bf16(cv[2] * sc, cv[3] * sc); wh.x = pk_bf16(cv[4] * sc, cv[5] * sc); wh.y = pk_bf16(cv[6] * sc, cv[7] * sc);
                        const int io = 8 * stl + rr, ipw = dir ? 63 - io : io;
                        if (part == 2) { *(LAS u32x2*)(vsw + ipw * 64 + col8) = wl; *(LAS u32x2*)(vsw + ipw * 64 + col8 + 4) = wh; }
                        else { LAS bf16_t* dst = (part == 0 ? qsw : ksw) + ipw * 72 + pb; *(LAS u32x2*)dst = wl; *(LAS u32x2*)(dst + 8) = wh; }
                    }
                } else {
                    int ll = lane; asm volatile("" : "+v"(ll));
                    float g = neg_ea * softplusf_(av + dtb);
#pragma unroll
                    for (int off = 1; off < 64; off <<= 1) { const int src = dir ? ll + off : ll - off; const bool ok = (src >= 0) && (src < 64); const float y = shl_(g, ok ? src : ll); g += ok ? y : 0.f; }
                    const float tot = shl_(g, dir ? 0 : 63);
                    const int lp = dir ? 63 - ll : ll;
                    LAS float* scw = SC + (c2 & 3) * 256;
                    scw[lp] = g; scw[64 + lp] = sigmoidf_(btv); scw[128 + lp] = __expf(g); scw[192 + lp] = __expf(tot - g);
                    if (ll == 0) glv[c2 & 3] = __expf(tot);
                }
            }
            if (c1 >= 0 && c1 < 128) {
                int tl = tid; asm volatile("" : "+v"(tl));
                const int mi = (wid >> 1) & 1, nj = wid & 1, n = tl & 31, h = (tl >> 5) & 1;
                const LAS bf16_t* qsr = (const LAS bf16_t*)(lds + G_QS + (c1 & 1) * 9216); const LAS bf16_t* ksr = (const LAS bf16_t*)(lds + G_KS + (c1 & 1) * 9216);
                const LAS float* scb = SC + (c1 & 3) * 256;
                LAS bf16_t* att = (LAS bf16_t*)(lds + G_ATT + (c1 & 1) * 9216);
                if (!(mi == 0 && nj == 1)) {
                    f32x16 qkacc;
#pragma unroll
                    for (int r = 0; r < 16; ++r) qkacc[r] = 0.f;
#pragma unroll
                    for (int k4 = 0; k4 < 4; ++k4)
                        qkacc = MFMA32(*(const LAS bf16x8*)(qsr + (32 * mi + n) * 72 + 16 * k4 + 8 * h), *(const LAS bf16x8*)(ksr + (32 * nj + n) * 72 + 16 * k4 + 8 * h), qkacc);
                    const int jp = 32 * nj + n; const float gj = scb[jp];
#pragma unroll
                    for (int r = 0; r < 16; ++r) {
                        const int ip = 32 * mi + (r & 3) + 8 * (r >> 2) + 4 * h;
                        const float e = __expf(fminf(scb[ip] - gj, 0.f));
                        const float v = (ip >= jp) ? qkacc[r] * e : 0.f;
                        att[ip * 72 + jp] = (bf16_t)(pk_bf16(v, 0.f) & 0xffffu);
                    }
                }
                {
                    const int t2 = tl & 255, row = t2 >> 2, p0 = (t2 & 3) * 16;
                    const u32x4 a = *(const LAS u32x4*)(ksr + row * 72 + p0), b = *(const LAS u32x4*)(ksr + row * 72 + p0 + 8);
                    LAS bf16_t* kt = (LAS bf16_t*)(lds + G_KT + (c1 & 1) * 9216) + p0 * 72 + row;
                    const unsigned ww[8] = {a.x, a.y, a.z, a.w, b.x, b.y, b.z, b.w};
#pragma unroll
                    for (int e = 0; e < 8; ++e) {
                        const int d0 = ((2 * e) & 3) | (((2 * e) & 4) << 1) | (((2 * e) & 8) >> 1), d1 = d0 + 1;
                        kt[d0 * 72] = (bf16_t)(ww[e] & 0xffffu); kt[d1 * 72] = (bf16_t)(ww[e] >> 16);
                    }
                }
            }
        }
        __syncthreads();
    }
#undef GDN_LOAD
}
__device__ void phase_mix(const P& p, int layer, LAS unsigned char* lds) {
    const int G = gridDim.x, b = blockIdx.x;
    const int nscan = G < 192 ? G : 192;
    if (b < nscan) for (int chain = b; chain < 192; chain += nscan) gdn_chain(p, layer, chain, lds);
    const int na = G - nscan;
    if (na > 0) { if (b >= nscan) for (int item = b - nscan; item < 1536; item += na) attn_item(p, layer, item, lds); }
    else { __syncthreads(); for (int item = b; item < 1536; item += G) attn_item(p, layer, item, lds); }
}
__device__ void phase_combine(const P& p, int layer) {
    const int tid_ = opaque_tid(), wid = tid_ >> 6, lane = tid_ & 63, c0 = lane * 8;
    unsigned char* reg = p.ws + REG_OFF;
    const bf16_t* OF = (const bf16_t*)(reg + R_OF); const bf16_t* OB = (const bf16_t*)(reg + R_OB); const bf16_t* Z = (const bf16_t*)(reg + R_Z);
    bf16_t* DNO = (bf16_t*)(reg + R_DNO);
    const float* nwp = p.norm_w + layer * 64 + (c0 & 63);
    const f32x4 nw0 = *(const f32x4*)nwp, nw1 = *(const f32x4*)(nwp + 4);
    for (int tok = blockIdx.x * 8 + wid; tok < T_TOK; tok += gridDim.x * 8) {
        const size_t off = (size_t)tok * 512 + c0;
        const u32x4 a = *(const u32x4*)(OF + off), b = *(const u32x4*)(OB + off), z = *(const u32x4*)(Z + off);
        float o[8] = {bf_lo(a.x) + bf_lo(b.x), bf_hi(a.x) + bf_hi(b.x), bf_lo(a.y) + bf_lo(b.y), bf_hi(a.y) + bf_hi(b.y), bf_lo(a.z) + bf_lo(b.z), bf_hi(a.z) + bf_hi(b.z), bf_lo(a.w) + bf_lo(b.w), bf_hi(a.w) + bf_hi(b.w)};
        const float zz[8] = {bf_lo(z.x), bf_hi(z.x), bf_lo(z.y), bf_hi(z.y), bf_lo(z.z), bf_hi(z.z), bf_lo(z.w), bf_hi(z.w)};
        float ss = 0.f;
#pragma unroll
        for (int e = 0; e < 8; ++e) ss += o[e] * o[e];
        ss += shx(ss, 1, lane); ss += shx(ss, 2, lane); ss += shx(ss, 4, lane);
        const float rs = rsqrtf(ss * (1.0f / 64.0f) + 1e-6f);
#pragma unroll
        for (int e = 0; e < 8; ++e) o[e] = o[e] * rs * (e < 4 ? nw0[e & 3] : nw1[e & 3]) * siluf_(zz[e]);
        u32x4 w; w.x = pk_bf16(o[0], o[1]); w.y = pk_bf16(o[2], o[3]); w.z = pk_bf16(o[4], o[5]); w.w = pk_bf16(o[6], o[7]);
        *(u32x4*)(DNO + off) = w;
    }
}

constexpr int PH_PER_LAYER = 12, NPH = 1 + 2 * PH_PER_LAYER;
__device__ void run_phase(const P& p, int ph, LAS unsigned char* lds) {
    if (ph == 0) { phase_convert(p, lds); return; }
    const int l = (ph - 1) / PH_PER_LAYER, q = (ph - 1) % PH_PER_LAYER;
    unsigned char* reg = p.ws + REG_OFF;
    const bf16_t* W = (const bf16_t*)p.ws + (size_t)l * W_LAYER;
    bf16_t* xb = (bf16_t*)(p.ws + XB_OFF);
    pg8::StaticOrder S;
    switch (q) {
    case 0: case 9: {
        S.init(T_TOK, 2 * DFF, gridDim.x, blockIdx.x);
        EpiBf E; E.mode = 0; E.O = (bf16_t*)(reg + R_H); E.O2 = nullptr; E.bias = nullptr; E.reg = reg;
        pg8::gemm_phase(lds, pg8::Gemm{xb, W + (q == 0 ? W_GU0 : W_GU1), T_TOK, 2 * DFF, DM}, S, E);
    } break;
    case 1: case 10: {
        S.init(T_TOK, DM, gridDim.x, blockIdx.x);
        EpiResid E; E.out = p.out; E.s = 0.5f;
        if (l == 0 && q == 1) { E.res0 = p.x_prompt; E.res1 = p.x_sample; E.split_row = T_PROMPT; } else { E.res0 = p.out; E.res1 = p.out; E.split_row = T_TOK; }
        pg8::gemm_phase(lds, pg8::Gemm{(const bf16_t*)(reg + R_H), W + (q == 1 ? W_D0 : W_D1), T_TOK, DM, DFF}, S, E);
    } break;
    case 2: phase_ln(p, l * 3 + 0); break;
    case 8: phase_ln(p, l * 3 + 1); break;
    case 11: phase_ln(p, l * 3 + 2); break;
    case 3: {
        S.init(T_TOK, 3072, gridDim.x, blockIdx.x);
        EpiBf E; E.mode = 1; E.O = nullptr; E.O2 = nullptr; E.bias = nullptr; E.reg = reg;
        pg8::gemm_phase(lds, pg8::Gemm{xb, W + W_PR, T_TOK, 3072, DM}, S, E);
    } break;
    case 4: phase_mix(p, l, lds); break;
    case 5: phase_combine(p, l); break;
    case 6: {
        S.init(T_TOK, DM, gridDim.x, blockIdx.x);
        EpiBf E; E.reg = reg; E.O = (bf16_t*)(reg + R_M); E.O2 = (const bf16_t*)(reg + R_M2); E.bias = nullptr;
        E.mode = 2; pg8::gemm_phase(lds, pg8::Gemm{(const bf16_t*)(reg + R_AQ), W + W_AT, T_TOK, DM, 512}, S, E);
        E.mode = 3; E.bias = p.b_gate + (size_t)l * 2048; pg8::gemm_phase(lds, pg8::Gemm{xb, W + W_GT, T_TOK, DM, DM}, S, E);
        E.mode = 2; E.O = (bf16_t*)(reg + R_M2); pg8::gemm_phase(lds, pg8::Gemm{(const bf16_t*)(reg + R_DNO), W + W_DN, T_TOK, DM, 512}, S, E);
        E.mode = 4; E.O = (bf16_t*)(reg + R_M); E.bias = p.b_gate + (size_t)l * 2048 + 1024; pg8::gemm_phase(lds, pg8::Gemm{xb, W + W_GT + (size_t)DM * DM, T_TOK, DM, DM}, S, E);
    } break;
    case 7: {
        S.init(T_TOK, DM, gridDim.x, blockIdx.x);
        EpiResid E; E.out = p.out; E.s = 1.0f; E.res0 = p.out; E.res1 = p.out; E.split_row = T_TOK;
        pg8::gemm_phase(lds, pg8::Gemm{(const bf16_t*)(reg + R_M), W + W_WO, T_TOK, DM, DM}, S, E);
    } break;
    }
}

__global__ __launch_bounds__(512, 2) void mega(P p, int ph_lo, int ph_hi) {
    extern __shared__ __attribute__((aligned(16))) unsigned char shm[];
    LAS unsigned char* lds = (LAS unsigned char*)shm;
    for (int ph = ph_lo; ph < ph_hi; ++ph) {
        if (ph > ph_lo) cg::this_grid().sync();
        run_phase(p, ph, lds);
    }
}

extern "C" void kernel_launch(void* const* d_in, const int* in_sizes, int n_in, void* d_out, int out_size, void* d_ws, size_t ws_size, hipStream_t stream) {
    static int grid_blocks = 0;
    if (!grid_blocks) {
        hipFuncSetAttribute((const void*)mega, hipFuncAttributeMaxDynamicSharedMemorySize, LDS_BYTES);
        int dev = 0, cus = 0, per_cu = 0;
        hipGetDevice(&dev);
        hipDeviceGetAttribute(&cus, hipDeviceAttributeMultiprocessorCount, dev);
        hipOccupancyMaxActiveBlocksPerMultiprocessor(&per_cu, mega, 512, LDS_BYTES);
        if (per_cu < 1) per_cu = 1;
        if (per_cu > 1) per_cu = 1;
        grid_blocks = cus * per_cu;
        if (ws_size < WS_NEED) fprintf(stderr, "workspace too small: %zu < %zu\n", ws_size, (size_t)WS_NEED);
    }
    P p{};
    p.x_prompt = (const float*)d_in[0]; p.x_sample = (const float*)d_in[1]; p.ln_g = (const float*)d_in[2]; p.ln_b = (const float*)d_in[3];
    p.w_fg = (const float*)d_in[4]; p.w_fu = (const float*)d_in[5]; p.w_fd = (const float*)d_in[6]; p.w_in = (const float*)d_in[7];
    p.sink = (const float*)d_in[8]; p.rel_bias = (const float*)d_in[9]; p.conv = (const float*)d_in[10]; p.a_log = (const float*)d_in[11];
    p.dt_bias = (const float*)d_in[12]; p.norm_w = (const float*)d_in[13]; p.w_att = (const float*)d_in[14]; p.w_dn = (const float*)d_in[15];
    p.w_gate = (const float*)d_in[16]; p.b_gate = (const float*)d_in[17]; p.w_o = (const float*)d_in[18];
    p.out = (float*)d_out; p.ws = (unsigned char*)d_ws;
#if SINGLE_LAUNCH
    int lo = 0, hi = NPH;
    void* args[] = {&p, &lo, &hi};
    hipError_t e = hipLaunchCooperativeKernel((const void*)mega, dim3(grid_blocks), dim3(512), args, LDS_BYTES, stream);
    if (e != hipSuccess) fprintf(stderr, "cooperative launch failed: %s (grid %d)\n", hipGetErrorString(e), grid_blocks);
#else
    for (int ph = 0; ph < NPH; ++ph) mega<<<dim3(grid_blocks), dim3(512), LDS_BYTES, stream>>>(p, ph, ph + 1);
#endif
}
```
